# Optimizing an MI355X kernel written in HIP

```python
import math
import jax, jax.numpy as jnp
from jax import lax
import numpy as np

D_MODEL = 1024
BATCH = 8
SEQ = 4096
DEPTH = 4

GRID_W = 64
CTX_LEN = 256

RWKV_HEADS = 8
RWKV_HEAD_DIM = 64
RWKV_WIDTH = RWKV_HEADS * RWKV_HEAD_DIM
DECAY_LORA = 64
AAA_LORA = 64
GN_EPS = 64e-5
NA_HEADS = 8
NA_HEAD_DIM = 64
NA_WIDTH = NA_HEADS * NA_HEAD_DIM
NA_WIN_R = 8
NA_WIN_C = 16
DIFF_HEADS = 4
DIFF_QK_DIM = 64
DIFF_V_DIM = 2 * DIFF_QK_DIM
DIFF_WIDTH = DIFF_HEADS * DIFF_V_DIM
Q_BLOCK = 128
ROPE_THETA = 10000.0
SUBLN_EPS = 1e-5
N_BRANCH = 3
BRANCH_WIDTH = 512
RMS_EPS = 1e-6
NEG_INF = -1e30

RWKV_SHIFT_WIDTH = 3 * RWKV_WIDTH + 2 * DECAY_LORA + 2 * AAA_LORA
DIFF_QKV_WIDTH = 2 * (DIFF_HEADS * 2 * DIFF_QK_DIM) + DIFF_WIDTH
IN_SIZES = (RWKV_SHIFT_WIDTH, RWKV_WIDTH,
            3 * NA_WIDTH, NA_WIDTH,
            DIFF_QKV_WIDTH, DIFF_WIDTH,
            N_BRANCH * D_MODEL)
D_IN = sum(IN_SIZES)

kernel_name = "hybrid_rwkv7_natten_diffattn_parallel_block"


def _split(z, sizes):
    return jnp.split(z, [int(i) for i in np.cumsum(sizes)[:-1]], axis=-1)


def _rmsnorm(x, g, eps=RMS_EPS):
    xf = x.astype(jnp.float32)
    y = xf * lax.rsqrt(jnp.mean(xf * xf, axis=-1, keepdims=True) + eps)
    return (y * g.astype(jnp.float32)).astype(x.dtype)


def _token_shift(u, mu_prev, mu_next):
    zeros = jnp.zeros_like(u[:, :1])
    u_prev = jnp.concatenate([zeros, u[:, :-1]], axis=1)
    u_next = jnp.concatenate([u[:, 1:], zeros], axis=1)
    return u + mu_prev * (u_prev - u) + mu_next * (u_next - u)


def _rwkv_scan(r, decay, k, v, kk, a, s0, reverse, with_out):
    seq = lambda t: jnp.moveaxis(t, 1, 0)
    xs = (seq(decay), seq(k), seq(v), seq(-kk), seq(kk * a), seq(r) if with_out else None)

    def step(s, inp):
        w_t, k_t, v_t, a_t, b_t, r_t = inp
        sa = jnp.einsum('bhij,bhj->bhi', s, a_t)
        s = s * w_t[:, :, None, :] + sa[..., None] * b_t[:, :, None, :] + v_t[..., None] * k_t[:, :, None, :]
        y = jnp.einsum('bhij,bhj->bhi', s, r_t) if with_out else None
        return s, y

    s_fin, ys = lax.scan(step, s0, xs, reverse=reverse)
    return s_fin, (jnp.moveaxis(ys, 0, 1) if with_out else None)


def _rwkv_branch(u_x, u_c, k_k, k_a, r_k, w0, w_up, a0, a_up, ln_g, ln_b, with_ctx_out):
    f32 = jnp.float32

    def prep(u):
        B, T, _ = u.shape
        r, k, v, wf, wb, af, ab = _split(u.astype(f32), (RWKV_WIDTH, RWKV_WIDTH, RWKV_WIDTH,
                                                         DECAY_LORA, DECAY_LORA, AAA_LORA, AAA_LORA))
        hd = lambda t: t.reshape(B, T, RWKV_HEADS, RWKV_HEAD_DIM)
        kk = hd(k * k_k)
        kk = kk / jnp.maximum(jnp.sqrt(jnp.sum(kk * kk, axis=-1, keepdims=True)), 1e-12)
        dirs = []
        for d, (wd, ad) in enumerate(((wf, af), (wb, ab))):
            w_log = -jax.nn.softplus(-(w0[d] + jnp.tanh(wd) @ w_up[d])) - 0.5
            a = jax.nn.sigmoid(a0[d] + ad @ a_up[d])
            k_dir = k * (1.0 + (a - 1.0) * k_a)
            dirs.append((hd(jnp.exp(-jnp.exp(w_log))), hd(k_dir), hd(a)))
        return hd(r), hd(v), kk, dirs

    def readout(y, r, v, k_dirs):
        B, T = y.shape[:2]
        mu = jnp.mean(y, axis=-1, keepdims=True)
        var = jnp.mean(jnp.square(y - mu), axis=-1, keepdims=True)
        yn = ((y - mu) * lax.rsqrt(var + GN_EPS)).reshape(B, T, RWKV_WIDTH) * ln_g + ln_b
        bonus = sum(jnp.sum(r * kd * r_k, axis=-1, keepdims=True) * v for kd in k_dirs)
        return yn + bonus.reshape(B, T, RWKV_WIDTH)

    r_c, v_c, kk_c, dirs_c = prep(u_c)
    r_x, v_x, kk_x, dirs_x = prep(u_x)
    s0 = jnp.zeros((u_x.shape[0], RWKV_HEADS, RWKV_HEAD_DIM, RWKV_HEAD_DIM), f32)
    ys_x, ys_c = [], []
    for d, reverse in enumerate((False, True)):
        dec_c, k_c, a_c = dirs_c[d]
        s_ctx, y_cd = _rwkv_scan(r_c, dec_c, k_c, v_c, kk_c, a_c, s0, reverse, with_ctx_out)
        dec_x, k_x, a_x = dirs_x[d]
        _, y_xd = _rwkv_scan(r_x, dec_x, k_x, v_x, kk_x, a_x, s_ctx, reverse, True)
        ys_x.append(y_xd)
        ys_c.append(y_cd)
    o_x = readout(ys_x[0] + ys_x[1], r_x, v_x, [dirs_x[0][1], dirs_x[1][1]])
    o_c = readout(ys_c[0] + ys_c[1], r_c, v_c, [dirs_c[0][1], dirs_c[1][1]]) if with_ctx_out else None
    return o_x, o_c


def _na_branch(qkv_x, qkv_c, rpb, with_ctx_out):
    f32 = jnp.float32
    B, S, _ = qkv_x.shape
    rows = S // GRID_W
    wr = min(NA_WIN_R, rows)
    scale = NA_HEAD_DIM ** -0.5

    def heads(t):
        return t.reshape(t.shape[0], t.shape[1], NA_HEADS, NA_HEAD_DIM).transpose(0, 2, 1, 3)

    q, k, v = (heads(t) for t in jnp.split(qkv_x, 3, axis=-1))
    qc, kc, vc = (heads(t) for t in jnp.split(qkv_c, 3, axis=-1))
    grid = lambda t: t.reshape(B, NA_HEADS, rows, GRID_W, NA_HEAD_DIM)
    q, k, v = grid(q) * scale, grid(k), grid(v)

    r_idx = jnp.arange(rows)
    r_start = jnp.clip(r_idx - wr // 2, 0, rows - wr)
    key_rows = r_start[:, None] + jnp.arange(wr)[None, :]
    kg = k[:, :, key_rows]
    vg = v[:, :, key_rows]
    c_idx = jnp.arange(GRID_W)
    c_start = jnp.clip(c_idx - NA_WIN_C // 2, 0, GRID_W - NA_WIN_C)
    col_ok = (c_idx[None, :] >= c_start[:, None]) & (c_idx[None, :] < c_start[:, None] + NA_WIN_C)
    dr = key_rows - r_idx[:, None] + (NA_WIN_R - 1)
    dc = jnp.clip(c_idx[None, :] - c_idx[:, None], -(NA_WIN_C - 1), NA_WIN_C - 1) + (NA_WIN_C - 1)
    bias = rpb[:, dr[:, None, :, None], dc[None, :, None, :]].astype(f32)

    s_nb = jnp.einsum('bhrqd,bhrwkd->bhrqwk', q, kg).astype(f32) + bias
    s_nb = jnp.where(col_ok[:, None, :], s_nb, NEG_INF)
    s_c = jnp.einsum('bhrqd,bhld->bhrql', q, kc).astype(f32)
    m = jnp.maximum(jnp.max(s_nb, axis=(-2, -1)), jnp.max(s_c, axis=-1))[..., None]
    p_nb = jnp.exp(s_nb - m[..., None])
    p_c = jnp.exp(s_c - m)
    denom = jnp.sum(p_nb, axis=(-2, -1)) + jnp.sum(p_c, axis=-1)
    o = (jnp.einsum('bhrqwk,bhrwkd->bhrqd', p_nb, vg.astype(f32))
         + jnp.einsum('bhrql,bhld->bhrqd', p_c, vc.astype(f32))) / denom[..., None]
    o_x = o.reshape(B, NA_HEADS, S, NA_HEAD_DIM).transpose(0, 2, 1, 3).reshape(B, S, NA_WIDTH)
    o_c = None
    if with_ctx_out:
        pc = jax.nn.softmax(jnp.einsum('bhqd,bhkd->bhqk', qc * scale, kc).astype(f32), axis=-1)
        oc = jnp.einsum('bhqk,bhkd->bhqd', pc, vc.astype(f32))
        o_c = oc.transpose(0, 2, 1, 3).reshape(B, qkv_c.shape[1], NA_WIDTH)
    return o_x, o_c


def _rope_tables(n_tokens):
    t = jnp.arange(n_tokens, dtype=jnp.int32)
    row = (t // GRID_W).astype(jnp.float32)
    col = (t % GRID_W).astype(jnp.float32)
    axis_dim = DIFF_QK_DIM // 2
    inv = ROPE_THETA ** (-jnp.arange(0, axis_dim, 2, dtype=jnp.float32) / axis_dim)
    ar = row[:, None] * inv
    ac = col[:, None] * inv
    ang = jnp.concatenate([ar, ar, ac, ac], axis=-1)
    return jnp.cos(ang), jnp.sin(ang)


def _apply_rope_2d(x, cos, sin):
    xf = x.astype(jnp.float32)
    xs = xf.reshape(xf.shape[:-1] + (2, 2, DIFF_QK_DIM // 4))
    rot = jnp.stack([-xs[..., 1, :], xs[..., 0, :]], axis=-2).reshape(xf.shape)
    cb = cos[None, :, None, None, :]
    sb = sin[None, :, None, None, :]
    return (xf * cb + rot * sb).astype(x.dtype)


def _diff_branch(z_x, z_c, lam_q, lam_k, subln_g, lambda_init, cos, sin, with_ctx_out):
    f32 = jnp.float32
    qk_w = DIFF_HEADS * 2 * DIFF_QK_DIM
    scale = DIFF_QK_DIM ** -0.5

    def split(z):
        B, T, _ = z.shape
        q, k, v = _split(z, (qk_w, qk_w, DIFF_WIDTH))
        q = q.reshape(B, T, DIFF_HEADS, 2, DIFF_QK_DIM)
        k = k.reshape(B, T, DIFF_HEADS, 2, DIFF_QK_DIM)
        v = v.reshape(B, T, DIFF_HEADS, DIFF_V_DIM)
        return q, k, v

    qx, kx, vx = split(z_x)
    qc, kc, vc = split(z_c)
    qx = _apply_rope_2d(qx, cos, sin)
    kx = _apply_rope_2d(kx, cos, sin)
    to_h = lambda t: t.transpose(0, 2, 3, 1, 4)
    qx, kx, qc, kc = to_h(qx), to_h(kx), to_h(qc), to_h(kc)
    vx, vc = vx.transpose(0, 2, 1, 3), vc.transpose(0, 2, 1, 3)
    lam = (jnp.exp(jnp.sum(lam_q[0] * lam_k[0]).astype(f32))
           - jnp.exp(jnp.sum(lam_q[1] * lam_k[1]).astype(f32)) + lambda_init)

    def attend(qb, keys, vals):
        s = jnp.einsum('bhmqd,bhmkd->bhmqk', qb, keys).astype(f32) * scale
        p = jax.nn.softmax(s, axis=-1)
        w = p[:, :, 0] - lam * p[:, :, 1]
        return jnp.einsum('bhqk,bhkv->bhqv', w, vals.astype(f32))

    def post(o):
        o = o.transpose(0, 2, 1, 3)
        o = _rmsnorm(o, subln_g, SUBLN_EPS) * (1.0 - lambda_init)
        return o.reshape(o.shape[0], o.shape[1], DIFF_WIDTH)

    B, H, _, S, d = qx.shape
    keys = jnp.concatenate([kx, kc], axis=3)
    vals = jnp.concatenate([vx, vc], axis=2)
    nblk = S // Q_BLOCK
    qb = jnp.moveaxis(qx.reshape(B, H, 2, nblk, Q_BLOCK, d), 3, 0)
    ob = lax.map(lambda blk: attend(blk, keys, vals), qb)
    o_x = post(jnp.moveaxis(ob, 0, 2).reshape(B, H, S, DIFF_V_DIM))
    o_c = post(attend(qc, kc, vc)) if with_ctx_out else None
    return o_x, o_c


def _mixer(hx, hc, w_in, mu, k_k, k_a, r_k, w0, w_up, a0, a_up, ln_g, ln_b, rpb,
           lam_q, lam_k, subln_g, w_branch, w_out, lambda_init, cos, sin, with_ctx_out):
    zx = hx @ w_in
    zc = hc @ w_in
    rw_x, rg_x, na_x, ng_x, df_x, dg_x, mg_x = _split(zx, IN_SIZES)
    rw_c, rg_c, na_c, ng_c, df_c, dg_c, mg_c = _split(zc, IN_SIZES)
    rw_x = _token_shift(rw_x, mu[0], mu[1])
    rw_c = _token_shift(rw_c, mu[0], mu[1])
    o_rw_x, o_rw_c = _rwkv_branch(rw_x, rw_c, k_k, k_a, r_k, w0, w_up, a0, a_up, ln_g, ln_b, with_ctx_out)
    o_na_x, o_na_c = _na_branch(na_x, na_c, rpb, with_ctx_out)
    o_df_x, o_df_c = _diff_branch(df_x, df_c, lam_q, lam_k, subln_g, lambda_init, cos, sin, with_ctx_out)

    def merge(outs, gates, mg):
        o = jnp.stack([ob.astype(g.dtype) * jax.nn.silu(g) for ob, g in zip(outs, gates)], axis=2)
        yb = jnp.einsum('btnc,ncd->btnd', o, w_branch)
        gb = jax.nn.sigmoid(mg.reshape(mg.shape[:2] + (N_BRANCH, D_MODEL)))
        return jnp.einsum('btd,de->bte', jnp.sum(gb * yb, axis=2), w_out).astype(hx.dtype)

    y_x = merge((o_rw_x, o_na_x, o_df_x), (rg_x, ng_x, dg_x), mg_x)
    y_c = merge((o_rw_c, o_na_c, o_df_c), (rg_c, ng_c, dg_c), mg_c) if with_ctx_out else None
    return y_x, y_c


def setup_inputs(seed: int = 0) -> dict:
    key = jax.random.key(seed)
    ks = jax.random.split(key, 26)
    f32 = jnp.float32
    D, L = D_MODEL, DEPTH
    nrm = lambda k, shape, s: jax.random.normal(k, shape, f32) * s
    return {
        "x": nrm(ks[0], (BATCH, SEQ, D), 1.0),
        "c": nrm(ks[1], (BATCH, D), 1.0),
        "ctx": nrm(ks[2], (BATCH, CTX_LEN, D), 1.0),
        "c_ctx": nrm(ks[3], (D,), 1.0),
        "w_mod": nrm(ks[4], (L, D, 3 * D), 0.5 * D ** -0.5),
        "b_mod": nrm(ks[5], (L, 3 * D), 0.02),
        "g_pre": 1.0 + nrm(ks[6], (L, D), 0.05),
        "g_post": 1.0 + nrm(ks[7], (L, D), 0.05),
        "w_in": nrm(ks[8], (L, D, D_IN), D ** -0.5),
        "shift_mu": jax.random.uniform(ks[9], (L, 2, RWKV_SHIFT_WIDTH), f32, 0.0, 0.5),
        "k_k": 0.85 + nrm(ks[10], (L, RWKV_WIDTH), 0.05),
        "k_a": 1.0 + nrm(ks[11], (L, RWKV_WIDTH), 0.05),
        "r_k": nrm(ks[12], (L, RWKV_HEADS, RWKV_HEAD_DIM), 0.1),
        "w0": jax.random.uniform(ks[13], (L, 2, RWKV_WIDTH), f32, -6.0, -1.0),
        "w_up": nrm(ks[14], (L, 2, DECAY_LORA, RWKV_WIDTH), 0.1),
        "a0": nrm(ks[15], (L, 2, RWKV_WIDTH), 0.1),
        "a_up": nrm(ks[16], (L, 2, AAA_LORA, RWKV_WIDTH), 0.5 * AAA_LORA ** -0.5),
        "ln_x_g": 1.0 + nrm(ks[17], (L, RWKV_WIDTH), 0.05),
        "ln_x_b": nrm(ks[18], (L, RWKV_WIDTH), 0.02),
        "rpb": nrm(ks[19], (L, NA_HEADS, 2 * NA_WIN_R - 1, 2 * NA_WIN_C - 1), 0.1),
        "lam_q": nrm(ks[20], (L, 2, DIFF_QK_DIM), 0.1),
        "lam_k": nrm(ks[21], (L, 2, DIFF_QK_DIM), 0.1),
        "diff_subln": 1.0 + nrm(ks[22], (L, DIFF_V_DIM), 0.05),
        "w_branch": nrm(ks[23], (L, N_BRANCH, BRANCH_WIDTH, D), BRANCH_WIDTH ** -0.5),
        "w_out": nrm(ks[24], (L, D, D), D ** -0.5),
    }


def reference(x, c, ctx, c_ctx, w_mod, b_mod, g_pre, g_post, w_in, shift_mu, k_k, k_a, r_k,
              w0, w_up, a0, a_up, ln_x_g, ln_x_b, rpb, lam_q, lam_k, diff_subln, w_branch, w_out):
    S = x.shape[1]
    cos, sin = _rope_tables(S)
    hc = ctx
    for l in range(DEPTH):
        last = l == DEPTH - 1
        lambda_init = 0.8 - 0.6 * math.exp(-0.3 * l)
        mod_x = jax.nn.silu(c) @ w_mod[l] + b_mod[l]
        mod_c = jax.nn.silu(c_ctx) @ w_mod[l] + b_mod[l]
        sh_x, sc_x, gt_x = jnp.split(mod_x[:, None, :], 3, axis=-1)
        sh_c, sc_c, gt_c = jnp.split(mod_c, 3, axis=-1)
        hx = _rmsnorm(x, g_pre[l]) * (1.0 + sc_x) + sh_x
        hcn = _rmsnorm(hc, g_pre[l]) * (1.0 + sc_c) + sh_c
        y_x, y_c = _mixer(hx, hcn, w_in[l], shift_mu[l], k_k[l], k_a[l], r_k[l], w0[l], w_up[l],
                          a0[l], a_up[l], ln_x_g[l], ln_x_b[l], rpb[l], lam_q[l], lam_k[l],
                          diff_subln[l], w_branch[l], w_out[l], lambda_init, cos, sin,
                          not last)
        x = (x + gt_x * _rmsnorm(y_x, g_post[l])).astype(x.dtype)
        if not last:
            hc = (hc + gt_c * _rmsnorm(y_c, g_post[l])).astype(hc.dtype)
    return x
```

```cpp
#include <hip/hip_runtime.h>
#include <hip/hip_cooperative_groups.h>
#include <cstdio>
#include <cstdint>
namespace cg = cooperative_groups;
__device__ __forceinline__ int otid() { int t = threadIdx.x; asm volatile("" : "+v"(t)); return t; }
namespace pg8 {
#define PG8_LAS __attribute__((address_space(3)))
typedef unsigned short bf16_t;
typedef short bf16x8 __attribute__((ext_vector_type(8)));
typedef float f32x4 __attribute__((ext_vector_type(4)));
typedef unsigned u32x4 __attribute__((ext_vector_type(4)));
constexpr int BM = 256, BK = 64, HALF = 128, HTB = HALF * BK * 2  , STAGE_BYTES = 8 * HTB, NXCD = 8, WGM = 8;

__host__ __device__ __forceinline__ int lds_byte(int r, int c) { const int st = (r >> 4) * 2 + (c >> 5), rr = r & 15, cc = c & 31, ob = rr * 64 + cc * 2; return st * 1024 + (ob ^ (((ob >> 9) & 1) << 5)); }
__host__ __device__ __forceinline__ void stage_rc(int b, int& R, int& C) { const int st = b / 1024, sb = b % 1024, swz = sb ^ (((sb >> 9) & 1) << 5); R = (st >> 1) * 16 + swz / 64; C = (st & 1) * 32 + (swz % 64) / 2; }
__host__ __device__ __forceinline__ int perm32(int rho) { const int n = rho >> 4, i = rho & 15; return 8 * (i >> 2) + 4 * n + (i & 3); }

struct Unit { int pm, pn; };
struct Gemm { const bf16_t* A; const bf16_t* Bt; int M, N, K; };

struct StaticOrder {
    int nM, nN, nwg, G, c;
    __host__ __device__ void init(int M, int N, int G_, int c_) { nM = M / BM; nN = N / BM; nwg = nM * nN; G = G_; c = c_; }
    __host__ __device__ bool next(int i, Unit& u) const {
        const long L = (long)i * G + c; if (L >= nwg) return false;
        int wgid = (int)L; { const int q = nwg / NXCD, r = nwg % NXCD, xcd = wgid % NXCD, off = wgid / NXCD; wgid = (xcd < r ? xcd * (q + 1) : r * (q + 1) + (xcd - r) * q) + off; }
        const int nig = WGM * nN, gid = wgid / nig, fm = gid * WGM, gsz = (nM - fm) < WGM ? (nM - fm) : WGM;
        u.pm = fm + ((wgid % nig) % gsz); u.pn = (wgid % nig) / gsz; return true;
    }
    __device__ __forceinline__ void a_ready(const Unit&) const {}
    __device__ __forceinline__ void done(const Unit&) const {}
};

template <class Epi, class Sched, bool ALIGN_EPI = false, bool SP2 = false>
__device__ __forceinline__ void gemm_phase(PG8_LAS unsigned char* lds, const Gemm g, const Sched& S, const Epi& E) {
    const int tid = otid(), wid = __builtin_amdgcn_readfirstlane(tid >> 6), lane = tid & 63, wr = wid >> 2, wc = wid & 3, fr = lane & 15, fq = lane >> 4;
    const int K = g.K, nt = K / BK;
    unsigned voffA[2], voffB[2];
#pragma unroll
    for (int i = 0; i < 2; ++i) { int R, C; stage_rc(tid * 16 + i * 8192, R, C); const int Rb = Epi::PERM ? ((R & ~31) + perm32(R & 31)) : R;
        voffA[i] = (unsigned)(R * K + C) * 2u; voffB[i] = (unsigned)(Rb * K + C) * 2u; }
    const size_t kstep = (size_t)(BK * 2);
    const size_t hstep = (size_t)HALF * K * 2;
    const size_t tstep = 2 * hstep;
    const unsigned ldsw = (unsigned)wid * 1024u;
    const int aoff = lds_byte(wr * 64 + fr, fq * 8), boff = lds_byte(wc * 32 + fr, fq * 8);
#define PG8_SA(b, h) (((b) * 2 + (h)) * HTB)
#define PG8_SB(b, h) ((4 + (b) * 2 + (h)) * HTB)
#define PG8_STAGE(bufoff, gbase, voff) do { _Pragma("unroll") for (int _i = 0; _i < 2; ++_i) \
        __builtin_amdgcn_global_load_lds((const unsigned*)((const char*)(gbase) + (voff)[_i]), (PG8_LAS unsigned*)(lds + (bufoff) + ldsw + _i * 8192), 16, 0, 0); } while (0)
#define PG8_LDA(dst, b, h) do { _Pragma("unroll") for (int m = 0; m < 4; ++m) _Pragma("unroll") for (int k = 0; k < 2; ++k) dst[m][k] = *(const PG8_LAS bf16x8*)(lds + PG8_SA(b, h) + aoff + m * 2048 + k * 1024); } while (0)
#define PG8_LDB(dst, b, h) do { _Pragma("unroll") for (int n = 0; n < 2; ++n) _Pragma("unroll") for (int k = 0; k < 2; ++k) dst[n][k] = *(const PG8_LAS bf16x8*)(lds + PG8_SB(b, h) + boff + n * 2048 + k * 1024); } while (0)
#define PG8_MMA(ai, bj, At, Bt) do { __builtin_amdgcn_s_setprio(1); _Pragma("unroll") for (int m = 0; m < 4; ++m) _Pragma("unroll") for (int n = 0; n < 2; ++n) _Pragma("unroll") for (int k = 0; k < 2; ++k) \
        acc[ai][bj][m][n] = __builtin_amdgcn_mfma_f32_16x16x32_bf16(Bt[n][k], At[m][k], acc[ai][bj][m][n], 0, 0, 0); __builtin_amdgcn_s_setprio(0); } while (0)
#define PG8_WAIT_V(n) asm volatile("s_waitcnt vmcnt(" #n ")" ::: "memory")
#define PG8_WAIT_L(n) asm volatile("s_waitcnt lgkmcnt(" #n ")" ::: "memory")
#define PG8_BAR __builtin_amdgcn_s_barrier()
#define PG8_SCHED __builtin_amdgcn_sched_barrier(0)
    Unit cur, nxt; int ui = 0;
    if (!S.next(0, cur)) return;
    f32x4 acc[2][2][4][2];
#pragma unroll
    for (int a = 0; a < 2; ++a)
#pragma unroll
        for (int b = 0; b < 2; ++b)
#pragma unroll
            for (int m = 0; m < 4; ++m)
#pragma unroll
                for (int n = 0; n < 2; ++n) acc[a][b][m][n] = (f32x4){0.f, 0.f, 0.f, 0.f};
    bf16x8 At[4][2], B0[2][2], B1[2][2];
    const char* cA = (const char*)g.A + (size_t)cur.pm * tstep; const char* cB = (const char*)g.Bt + (size_t)cur.pn * tstep;
    S.a_ready(cur);
    if constexpr (SP2) {
        PG8_STAGE(PG8_SB(0, 0), cB, voffB); PG8_STAGE(PG8_SB(0, 1), cB + hstep, voffB); PG8_STAGE(PG8_SA(0, 0), cA, voffA); PG8_STAGE(PG8_SA(0, 1), cA + hstep, voffA);
        if (wr == 1) PG8_BAR;
        PG8_WAIT_V(2); PG8_BAR;
        PG8_STAGE(PG8_SB(1, 0), cB + kstep, voffB); PG8_STAGE(PG8_SA(1, 0), cA + kstep, voffA); PG8_STAGE(PG8_SB(1, 1), cB + hstep + kstep, voffB);
        PG8_WAIT_V(6); PG8_BAR;
    } else {
        PG8_STAGE(PG8_SB(0, 0), cB, voffB); PG8_STAGE(PG8_SA(0, 0), cA, voffA); PG8_STAGE(PG8_SB(0, 1), cB + hstep, voffB); PG8_STAGE(PG8_SA(0, 1), cA + hstep, voffA);
        if (wr == 1) PG8_BAR;
        PG8_WAIT_V(4); PG8_BAR;
        PG8_STAGE(PG8_SB(1, 0), cB + kstep, voffB); PG8_STAGE(PG8_SA(1, 0), cA + kstep, voffA); PG8_STAGE(PG8_SB(1, 1), cB + hstep + kstep, voffB);
        PG8_WAIT_V(6); PG8_BAR;
    }
    for (;;) {
        const bool has_next = S.next(ui + 1, nxt);
        const char* nA = has_next ? (const char*)g.A + (size_t)nxt.pm * tstep : cA; const char* nB = has_next ? (const char*)g.Bt + (size_t)nxt.pn * tstep : cB;
        for (int t = 0; t < nt; t += 2) {
            const bool last = (t == nt - 2);
            const char* a1 = cA + (size_t)(t + 1) * kstep;
            const char* a2 = last ? nA : cA + (size_t)(t + 2) * kstep; const char* b2 = last ? nB : cB + (size_t)(t + 2) * kstep;
            const char* a3 = a2 + kstep; const char* b3 = b2 + kstep;
            if (last && has_next) S.a_ready(nxt);
            if constexpr (SP2) {
            PG8_LDB(B0, 0, 0); PG8_LDB(B1, 0, 1); PG8_SCHED; PG8_LDA(At, 0, 0); PG8_STAGE(PG8_SA(1, 1), a1 + hstep, voffA);
            PG8_WAIT_V(8); PG8_WAIT_L(0); PG8_BAR; PG8_MMA(0, 0, At, B0); PG8_MMA(0, 1, At, B1); PG8_BAR; PG8_SCHED;
            PG8_LDA(At, 0, 1); PG8_STAGE(PG8_SB(0, 0), b2, voffB); PG8_STAGE(PG8_SB(0, 1), b2 + hstep, voffB); PG8_STAGE(PG8_SA(0, 0), a2, voffA);
            PG8_WAIT_V(8); PG8_WAIT_L(0); PG8_BAR; PG8_MMA(1, 0, At, B0); PG8_MMA(1, 1, At, B1); PG8_BAR; PG8_SCHED;
            PG8_LDB(B0, 1, 0); PG8_LDB(B1, 1, 1); PG8_SCHED; PG8_LDA(At, 1, 0); PG8_STAGE(PG8_SA(0, 1), a2 + hstep, voffA);
            PG8_WAIT_V(8); PG8_WAIT_L(0); PG8_BAR; PG8_MMA(0, 0, At, B0); PG8_MMA(0, 1, At, B1); PG8_BAR; PG8_SCHED;
            PG8_LDA(At, 1, 1); PG8_STAGE(PG8_SB(1, 0), b3, voffB); PG8_STAGE(PG8_SB(1, 1), b3 + hstep, voffB); PG8_STAGE(PG8_SA(1, 0), a3, voffA);
            PG8_WAIT_V(8); PG8_WAIT_L(0); PG8_BAR; PG8_MMA(1, 0, At, B0); PG8_MMA(1, 1, At, B1); PG8_BAR; PG8_SCHED;
            } else {
            PG8_LDB(B0, 0, 0); PG8_SCHED; PG8_LDA(At, 0, 0); PG8_STAGE(PG8_SA(1, 1), a1 + hstep, voffA);
            PG8_WAIT_L(8); PG8_BAR; PG8_WAIT_L(0); PG8_MMA(0, 0, At, B0); PG8_BAR; PG8_SCHED;
            PG8_LDB(B1, 0, 1); PG8_STAGE(PG8_SB(0, 0), b2, voffB);
            PG8_BAR; PG8_WAIT_L(0); PG8_MMA(0, 1, At, B1); PG8_BAR;
            PG8_LDA(At, 0, 1); PG8_STAGE(PG8_SA(0, 0), a2, voffA);
            PG8_BAR; PG8_WAIT_L(0); PG8_MMA(1, 0, At, B0); PG8_BAR; PG8_SCHED;
            PG8_STAGE(PG8_SB(0, 1), b2 + hstep, voffB);
            PG8_WAIT_V(6); PG8_BAR; PG8_MMA(1, 1, At, B1); PG8_BAR;
            PG8_LDB(B0, 1, 0); PG8_SCHED; PG8_LDA(At, 1, 0); PG8_STAGE(PG8_SA(0, 1), a2 + hstep, voffA);
            PG8_WAIT_L(8); PG8_BAR; PG8_WAIT_L(0); PG8_MMA(0, 0, At, B0); PG8_BAR; PG8_SCHED;
            PG8_LDB(B1, 1, 1); PG8_STAGE(PG8_SB(1, 0), b3, voffB);
            PG8_BAR; PG8_WAIT_L(0); PG8_MMA(0, 1, At, B1); PG8_BAR;
            PG8_LDA(At, 1, 1); PG8_STAGE(PG8_SA(1, 0), a3, voffA);
            PG8_BAR; PG8_WAIT_L(0); PG8_MMA(1, 0, At, B0); PG8_BAR; PG8_SCHED;
            PG8_STAGE(PG8_SB(1, 1), b3 + hstep, voffB);
            PG8_WAIT_V(6); PG8_BAR; PG8_MMA(1, 1, At, B1); PG8_BAR;
            }
        }
        if constexpr (ALIGN_EPI) { if (wr == 0) PG8_BAR; }
        if constexpr (!Epi::AFTER_DRAIN) { E(acc, cur, wr, wc, fr, fq); S.done(cur); }
        if (!has_next) break;
#pragma unroll
        for (int a = 0; a < 2; ++a)
#pragma unroll
            for (int b = 0; b < 2; ++b)
#pragma unroll
                for (int m = 0; m < 4; ++m)
#pragma unroll
                    for (int n = 0; n < 2; ++n) acc[a][b][m][n] = (f32x4){0.f, 0.f, 0.f, 0.f};
        cur = nxt; cA = nA; cB = nB; ++ui;
        if constexpr (ALIGN_EPI) { if (wr == 1) PG8_BAR; }
    }
    PG8_WAIT_V(0);
    if constexpr (!ALIGN_EPI) { if (wr == 0) PG8_BAR; }
    PG8_BAR;
    if constexpr (Epi::AFTER_DRAIN) { E.fused(acc, cur, wr, wc, fr, fq, lds, wid, lane); S.done(cur); }
#undef PG8_SA
#undef PG8_SB
#undef PG8_STAGE
#undef PG8_LDA
#undef PG8_LDB
#undef PG8_MMA
#undef PG8_WAIT_V
#undef PG8_WAIT_L
#undef PG8_BAR
#undef PG8_SCHED
}
}

#define LAS __attribute__((address_space(3)))
typedef unsigned short bf16_t;
typedef short bf16x8 __attribute__((ext_vector_type(8)));
typedef short s16x4 __attribute__((ext_vector_type(4)));
typedef float f32x4 __attribute__((ext_vector_type(4)));
typedef float f32x2 __attribute__((ext_vector_type(2)));
typedef float f32x16 __attribute__((ext_vector_type(16)));
typedef unsigned u32x4 __attribute__((ext_vector_type(4)));
typedef unsigned u32x2 __attribute__((ext_vector_type(2)));

constexpr int DM = 1024, NB = 8, SEQ = 4096, CTXL = 256, DEPTH = 4;
constexpr int TL = NB * SEQ;
constexpr int TC = NB * CTXL;
constexpr int T = TL + TC;
constexpr int NPM = T / 256;
constexpr int DIN = 9472, NMAIN = 6400;
constexpr float LOG2E = 1.4426950408889634f;
constexpr float QS = 0.125f * LOG2E;

constexpr size_t MiB = 1u << 20;
constexpr size_t WS_CTL = 0, WS_MODS = 1 * MiB, WS_ROPE = 1 * MiB + 512 * 1024, WS_BS = 2 * MiB, WS_HC = 5 * MiB;
constexpr size_t WS_WIN = 13 * MiB, WS_WBR = 32 * MiB, WS_WOUT = 35 * MiB;
constexpr size_t WS_ZRW = 37 * MiB, WS_NAQ = 156 * MiB, WS_G3 = 258 * MiB, WS_DFQ = 360 * MiB, WS_HX = 462 * MiB, WS_END = 530 * MiB;
constexpr size_t WS_SG = WS_ZRW, WS_YBUF = WS_ZRW, WS_MPART = WS_DFQ, WS_M = WS_HX;
constexpr int LDS_BYTES = 147456;
constexpr int NPHASE = 30;

struct Params { const float* in[25]; float* out; unsigned char* ws; int ph_lo, ph_hi; };
enum { I_X = 0, I_C, I_CTX, I_CCTX, I_WMOD, I_BMOD, I_GPRE, I_GPOST, I_WIN, I_MU, I_KK, I_KA, I_RK, I_W0, I_WUP, I_A0, I_AUP, I_LNG, I_LNB, I_RPB, I_LAMQ, I_LAMK, I_SUBLN, I_WBR, I_WOUT };

__device__ __forceinline__ float bf2f(unsigned u) { return __uint_as_float(u << 16); }
__device__ __forceinline__ unsigned f2bf(float f) { unsigned u = __float_as_uint(f); return (u + 0x7fffu + ((u >> 16) & 1u)) >> 16; }
typedef __bf16 hbf16x2 __attribute__((ext_vector_type(2)));
__device__ __forceinline__ unsigned pk2(float lo, float hi) { f32x2 v = {lo, hi}; hbf16x2 b = __builtin_convertvector(v, hbf16x2); return __builtin_bit_cast(unsigned, b); }
__device__ __forceinline__ float wave_sum(float v) {
#pragma unroll
    for (int o = 1; o < 64; o <<= 1) v += __shfl_xor(v, o);
    return v;
}
__device__ __forceinline__ float dpp_xor1(float v) { return __int_as_float(__builtin_amdgcn_update_dpp(0, __float_as_int(v), 0xB1, 0xF, 0xF, true)); }
__device__ __forceinline__ float dpp_xor2(float v) { return __int_as_float(__builtin_amdgcn_update_dpp(0, __float_as_int(v), 0x4E, 0xF, 0xF, true)); }
__device__ __forceinline__ float dpp_hmir(float v) { return __int_as_float(__builtin_amdgcn_update_dpp(0, __float_as_int(v), 0x141, 0xF, 0xF, true)); }
__device__ __forceinline__ float sum8(float v) { v += dpp_xor1(v); v += dpp_xor2(v); v += dpp_hmir(v); return v; }
__device__ __forceinline__ void unpack8(u32x4 w, float* f) {
    f[0] = bf2f(w.x & 0xffffu); f[1] = bf2f(w.x >> 16); f[2] = bf2f(w.y & 0xffffu); f[3] = bf2f(w.y >> 16);
    f[4] = bf2f(w.z & 0xffffu); f[5] = bf2f(w.z >> 16); f[6] = bf2f(w.w & 0xffffu); f[7] = bf2f(w.w >> 16);
}
__device__ __forceinline__ u32x4 pack8(const float* f) { u32x4 w; w.x = pk2(f[0], f[1]); w.y = pk2(f[2], f[3]); w.z = pk2(f[4], f[5]); w.w = pk2(f[6], f[7]); return w; }

struct Sched {
    int mode;
    pg8::StaticOrder so; int G, c;
    __device__ __forceinline__ bool next(int i, pg8::Unit& u) const {
        if (mode == 0) return so.next(i, u);
        const int tile = (i / 3) * G + c; if (tile >= NPM * 4) return false;
        const int n = i % 3; u.pm = n * NPM + (tile >> 2); u.pn = n * 4 + (tile & 3); return true;
    }
    __device__ __forceinline__ void a_ready(const pg8::Unit&) const {}
    __device__ __forceinline__ void done(const pg8::Unit&) const {}
};

struct Epi {
    static constexpr bool PERM = true, AFTER_DRAIN = false;
    int mode;
    bf16_t *zrw, *naq, *dfq, *g3, *sg, *mout; float *mpart, *ybuf; const f32x2* rope;
    __device__ __forceinline__ void operator()(const f32x4 (&acc)[2][2][4][2], const pg8::Unit& u, int wr_, int wc_, int fr_, int fq_) const {
        int tq = threadIdx.x; asm volatile("" : "+v"(tq));
        const int lane = tq & 63, wid = tq >> 6, wr = wid >> 2, wc = wid & 3, fr = lane & 15, fq = lane >> 4;
        if (mode <= 1) {
            const int pn = u.pn; unsigned char* base; int ldc, colt, act = 0; float scl = 1.f; bool rp = false;
            if (mode == 1) { base = (unsigned char*)sg; ldc = 3072; colt = pn * 256; act = 2; }
            else if (pn < 7) { base = (unsigned char*)zrw; ldc = 1792; colt = pn * 256; }
            else if (pn < 9) { base = (unsigned char*)g3; ldc = 512; colt = (pn - 7) * 256; act = 1; }
            else if (pn < 15) { base = (unsigned char*)naq; ldc = 1536; colt = (pn - 9) * 256; if (pn < 11) scl = QS; }
            else if (pn < 17) { base = (unsigned char*)(g3 + (size_t)T * 512); ldc = 512; colt = (pn - 15) * 256; act = 1; }
            else if (pn < 23) { base = (unsigned char*)dfq; ldc = 1536; colt = (pn - 17) * 256; if (pn < 19) scl = QS; rp = (pn < 21) && (u.pm < 128); }
            else { base = (unsigned char*)(g3 + (size_t)2 * T * 512); ldc = 512; colt = (pn - 23) * 256; act = 1; }
            const int row0 = u.pm * 256 + wr * 64 + fr, col0 = colt + wc * 32 + 8 * fq;
#pragma unroll
            for (int ai = 0; ai < 2; ++ai)
#pragma unroll
                for (int m = 0; m < 4; ++m) {
                    int row = row0 + ai * 128 + m * 16; asm volatile("" : "+v"(row));
                    const unsigned off = ((unsigned)row * (unsigned)ldc + (unsigned)col0) * 2u;
                    float cs[8], sn[8];
                    if (rp) {
                        const int t = row & 4095; const int pos = (wc & 1) ? (t & 63) : (t >> 6);
                        const f32x4* rt = (const f32x4*)(rope + pos * 16 + 8 * (fq & 1));
#pragma unroll
                        for (int e = 0; e < 4; ++e) { const f32x4 q = rt[e]; cs[2 * e] = q.x; sn[2 * e] = q.y; cs[2 * e + 1] = q.z; sn[2 * e + 1] = q.w; }
                    }
#pragma unroll
                    for (int bj = 0; bj < 2; ++bj) {
                        float v[8];
#pragma unroll
                        for (int e = 0; e < 4; ++e) { v[e] = acc[ai][bj][m][0][e]; v[4 + e] = acc[ai][bj][m][1][e]; }
                        if (rp) {
#pragma unroll
                            for (int e = 0; e < 8; ++e) { const float xp = __shfl_xor(v[e], 32); v[e] = (fq < 2) ? (v[e] * cs[e] - xp * sn[e]) : (v[e] * cs[e] + xp * sn[e]); }
                        }
                        if (act == 1) {
#pragma unroll
                            for (int e = 0; e < 8; ++e) v[e] = v[e] / (1.f + __expf(-v[e]));
                        } else if (act == 2) {
#pragma unroll
                            for (int e = 0; e < 8; ++e) v[e] = 1.f / (1.f + __expf(-v[e]));
                        }
#pragma unroll
                        for (int e = 0; e < 8; ++e) v[e] *= scl;
                        *(u32x4*)(base + off + bj * 256) = pack8(v);
                    }
                    asm volatile("" ::: "memory");
                }
        } else if (mode == 2) {
            const int n = u.pn >> 2, pn = u.pn & 3, pm = u.pm - n * NPM;
            float* part = mpart + (size_t)blockIdx.x * 65536;
            const unsigned char* sgb = (const unsigned char*)(sg + (size_t)pm * 256 * 3072 + n * 1024 + pn * 256);
            unsigned char* mb = (unsigned char*)(mout + (size_t)pm * 256 * 1024 + pn * 256);
            const int lr0 = wr * 64 + fr, lc0 = wc * 32 + 8 * fq;
#pragma unroll
            for (int ai = 0; ai < 2; ++ai)
#pragma unroll
                for (int m = 0; m < 4; ++m) {
                    int lr = lr0 + ai * 128 + m * 16; asm volatile("" : "+v"(lr));
#pragma unroll
                    for (int bj = 0; bj < 2; ++bj) {
                        const int lc = lc0 + bj * 128;
                        float g[8]; unpack8(*(const u32x4*)(sgb + ((unsigned)lr * 3072u + (unsigned)lc) * 2u), g);
                        float v[8];
#pragma unroll
                        for (int e = 0; e < 4; ++e) { v[e] = acc[ai][bj][m][0][e] * g[e]; v[4 + e] = acc[ai][bj][m][1][e] * g[4 + e]; }
                        float* pp = part + lr * 256 + lc;
                        if (n > 0) { const f32x4 a = *(const f32x4*)pp, b = *(const f32x4*)(pp + 4);
#pragma unroll
                            for (int e = 0; e < 4; ++e) { v[e] += a[e]; v[4 + e] += b[e]; } }
                        if (n < 2) { *(f32x4*)pp = (f32x4){v[0], v[1], v[2], v[3]}; *(f32x4*)(pp + 4) = (f32x4){v[4], v[5], v[6], v[7]}; }
                        else *(u32x4*)(mb + ((unsigned)lr * 1024u + (unsigned)lc) * 2u) = pack8(v);
                        asm volatile("" ::: "memory");
                    }
                }
        } else {
            const int row0 = u.pm * 256 + wr * 64 + fr, col0 = u.pn * 256 + wc * 32 + 8 * fq;
#pragma unroll
            for (int ai = 0; ai < 2; ++ai)
#pragma unroll
                for (int m = 0; m < 4; ++m) {
                    int row = row0 + ai * 128 + m * 16; asm volatile("" : "+v"(row));
                    float* rowp = ybuf + (size_t)row * 1024 + col0;
#pragma unroll
                    for (int bj = 0; bj < 2; ++bj) { *(f32x4*)(rowp + bj * 128) = acc[ai][bj][m][0]; *(f32x4*)(rowp + bj * 128 + 4) = acc[ai][bj][m][1]; }
                    asm volatile("" ::: "memory");
                }
        }
    }
};

__device__ __forceinline__ void transpose_item(const float* W, int K, int N, bf16_t* WT, LAS float* scr, int item, int lane) {
    const int nblk = N / 32, kb = item / nblk, nb = item % nblk, k0 = 64 * kb, n0 = 32 * nb;
#pragma unroll 8
    for (int i = 0; i < 32; ++i) { const int kk = 2 * i + (lane >> 5); scr[kk * 33 + (lane & 31)] = W[(size_t)(k0 + kk) * N + n0 + (lane & 31)]; }
    asm volatile("s_waitcnt lgkmcnt(0)" ::: "memory");
    const int c = lane & 7;
#pragma unroll
    for (int j = 0; j < 4; ++j) { const int n = (lane >> 3) + 8 * j; const LAS float* s = scr + (8 * c) * 33 + n;
        u32x4 o; o.x = pk2(s[0 * 33], s[1 * 33]); o.y = pk2(s[2 * 33], s[3 * 33]); o.z = pk2(s[4 * 33], s[5 * 33]); o.w = pk2(s[6 * 33], s[7 * 33]);
        *(u32x4*)(WT + (size_t)(n0 + n) * K + k0 + 8 * c) = o; }
    asm volatile("s_waitcnt lgkmcnt(0)" ::: "memory");
}
__device__ __forceinline__ void convert_weights(const Params& p, int l, unsigned char* lds) {
    const int tid_ = otid(); const int wave = tid_ >> 6, lane = tid_ & 63;
    LAS float* scr = (LAS float*)((LAS unsigned char*)lds + wave * 8704);
    const int gw = blockIdx.x * 8 + wave, NGW = gridDim.x * 8;
    constexpr int I_IN = 16 * (DIN / 32), I_BR = 8 * 32, I_OUT = 16 * 32, NITEMS = I_IN + 3 * I_BR + I_OUT;
    bf16_t* win = (bf16_t*)(p.ws + WS_WIN); bf16_t* wbr = (bf16_t*)(p.ws + WS_WBR); bf16_t* wout = (bf16_t*)(p.ws + WS_WOUT);
    for (int it = gw; it < NITEMS; it += NGW) {
        int r = it;
        if (r < I_IN) { transpose_item(p.in[I_WIN] + (size_t)l * 1024 * DIN, 1024, DIN, win, scr, r, lane); continue; } r -= I_IN;
        if (r < 3 * I_BR) { const int n = r / I_BR; transpose_item(p.in[I_WBR] + ((size_t)l * 3 + n) * 512 * 1024, 512, 1024, wbr + (size_t)n * 1024 * 512, scr, r % I_BR, lane); continue; } r -= 3 * I_BR;
        transpose_item(p.in[I_WOUT] + (size_t)l * 1024 * 1024, 1024, 1024, wout, scr, r, lane);
    }
}

__device__ __forceinline__ void phase_prologue(const Params& p, unsigned char* lds) {
    const int tid = otid(), wave = tid >> 6, lane = tid & 63;
    float* mods = (float*)(p.ws + WS_MODS);
    if (blockIdx.x < 192) {
        float* sc = (float*)lds;
        float* red = (float*)(lds + 36864);
        for (int i = tid; i < 9 * 1024; i += 512) { const float v = (i < 8192) ? p.in[I_C][i] : p.in[I_CCTX][i - 8192]; sc[i] = v / (1.f + __expf(-v)); }
        __syncthreads();
        const int l = blockIdx.x / 48, cb = blockIdx.x % 48, col = cb * 64 + lane;
        const float* W = p.in[I_WMOD] + (size_t)l * 1024 * 3072;
        float a[9];
#pragma unroll
        for (int v = 0; v < 9; ++v) a[v] = 0.f;
        for (int k = wave * 128; k < wave * 128 + 128; ++k) { const float w = W[(size_t)k * 3072 + col];
#pragma unroll
            for (int v = 0; v < 9; ++v) a[v] += sc[v * 1024 + k] * w; }
#pragma unroll
        for (int v = 0; v < 9; ++v) red[(wave * 9 + v) * 64 + lane] = a[v];
        __syncthreads();
        for (int i = tid; i < 9 * 64; i += 512) { const int v = i >> 6, cl = i & 63; float s = 0.f;
#pragma unroll
            for (int w = 0; w < 8; ++w) s += red[(w * 9 + v) * 64 + cl];
            mods[((size_t)l * 9 + v) * 3072 + cb * 64 + cl] = s + p.in[I_BMOD][l * 3072 + cb * 64 + cl]; }
        __syncthreads();
    } else if (blockIdx.x == 192) {
        f32x2* rope = (f32x2*)(p.ws + WS_ROPE);
        for (int i = tid; i < 1024; i += 512) { const int pos = i >> 4, fi = i & 15;
            const float inv = exp2f(-(float)fi * (13.287712379549449f / 16.f));
            const float x = (float)pos * inv; float s, c; sincosf(x, &s, &c); rope[i] = (f32x2){c, s}; }
    }
    convert_weights(p, 0, lds);
}

__device__ __forceinline__ void hx_from_row(const Params& p, int l, int v, const f32x4 (&x)[4], int lane, bf16_t* hxrow) {
    float ss = 0.f;
#pragma unroll
    for (int j = 0; j < 4; ++j) ss += (x[j].x * x[j].x + x[j].y * x[j].y) + (x[j].z * x[j].z + x[j].w * x[j].w);
    const float rx = rsqrtf(wave_sum(ss) * (1.f / 1024.f) + 1e-6f);
    const float* mods = (const float*)(p.ws + WS_MODS) + ((size_t)l * 9 + v) * 3072;
#pragma unroll
    for (int j = 0; j < 4; ++j) { const int c = 4 * lane + 256 * j;
        const f32x4 g = *(const f32x4*)(p.in[I_GPRE] + l * 1024 + c), sh = *(const f32x4*)(mods + c), scv = *(const f32x4*)(mods + 1024 + c);
        const f32x4 h = x[j] * rx * g * (scv + 1.f) + sh;
        u32x2 o; o.x = pk2(h.x, h.y); o.y = pk2(h.z, h.w); *(u32x2*)(hxrow + c) = o; }
}
__device__ __forceinline__ void phase_rowpass(const Params& p, int l) {
    const int tid_ = otid(); const int wave = tid_ >> 6, lane = tid_ & 63;
    const int gw = blockIdx.x * 8 + wave, NGW = gridDim.x * 8;
    const float* ybuf = (const float*)(p.ws + WS_YBUF); float* hc = (float*)(p.ws + WS_HC); bf16_t* hx = (bf16_t*)(p.ws + WS_HX);
    const int nrows = (l == DEPTH) ? TL : T;
    for (int row = gw; row < nrows; row += NGW) {
        const bool lat = row < TL; const int v = lat ? (row >> 12) : 8;
        const float* src = lat ? ((l <= 1 ? p.in[I_X] : (const float*)p.out) + (size_t)row * 1024) : ((l <= 1 ? p.in[I_CTX] : (const float*)hc) + (size_t)(row - TL) * 1024);
        f32x4 x[4];
#pragma unroll
        for (int j = 0; j < 4; ++j) x[j] = *(const f32x4*)(src + 4 * lane + 256 * j);
        if (l > 0) {
            f32x4 y[4]; float ss = 0.f;
#pragma unroll
            for (int j = 0; j < 4; ++j) { y[j] = *(const f32x4*)(ybuf + (size_t)row * 1024 + 4 * lane + 256 * j); ss += (y[j].x * y[j].x + y[j].y * y[j].y) + (y[j].z * y[j].z + y[j].w * y[j].w); }
            const float ry = rsqrtf(wave_sum(ss) * (1.f / 1024.f) + 1e-6f);
            const float* gate = (const float*)(p.ws + WS_MODS) + ((size_t)(l - 1) * 9 + v) * 3072 + 2048;
            float* dst = lat ? (p.out + (size_t)row * 1024) : (hc + (size_t)(row - TL) * 1024);
#pragma unroll
            for (int j = 0; j < 4; ++j) { const int c = 4 * lane + 256 * j;
                const f32x4 gp = *(const f32x4*)(p.in[I_GPOST] + (l - 1) * 1024 + c), gt = *(const f32x4*)(gate + c);
                x[j] = x[j] + gt * (y[j] * ry * gp); *(f32x4*)(dst + c) = x[j]; }
        }
        if (l < DEPTH) hx_from_row(p, l, v, x, lane, hx + (size_t)row * 1024);
    }
}

__device__ __forceinline__ void phase_readout(const Params& p, int l) {
    const int tid_ = otid(); const int wave = tid_ >> 6, lane = tid_ & 63;
    const int gw = blockIdx.x * 8 + wave, NGW = gridDim.x * 8;
    bf16_t* hx = (bf16_t*)(p.ws + WS_HX); const bf16_t* zrw = (const bf16_t*)(p.ws + WS_ZRW); bf16_t* g3 = (bf16_t*)(p.ws + WS_G3);
    const float* bs = (const float*)(p.ws + WS_BS); const float* hc = (const float*)(p.ws + WS_HC);
    const int c0 = 8 * lane, head = lane >> 3;
    float lg[8], lb[8], mp[8], mn[8];
#pragma unroll
    for (int e = 0; e < 8; ++e) { lg[e] = p.in[I_LNG][l * 512 + c0 + e]; lb[e] = p.in[I_LNB][l * 512 + c0 + e];
        mp[e] = p.in[I_MU][(size_t)(l * 2 + 0) * 1792 + 1024 + c0 + e]; mn[e] = p.in[I_MU][(size_t)(l * 2 + 1) * 1792 + 1024 + c0 + e]; }
    for (int row = gw; row < T; row += NGW) {
        const bool lat = row < TL; const int v = lat ? (row >> 12) : 8;
        const int tpos = lat ? (row & 4095) : ((row - TL) & 255), slen = lat ? SEQ : CTXL;
        float yf[8], yb[8], z[8], zp[8], zn[8], g[8];
        unpack8(*(const u32x4*)(hx + (size_t)row * 1024 + c0), yf); unpack8(*(const u32x4*)(hx + (size_t)row * 1024 + 512 + c0), yb);
        unpack8(*(const u32x4*)(zrw + (size_t)row * 1792 + 1024 + c0), z);
        if (tpos > 0) unpack8(*(const u32x4*)(zrw + (size_t)(row - 1) * 1792 + 1024 + c0), zp); else {
#pragma unroll
            for (int e = 0; e < 8; ++e) zp[e] = 0.f; }
        if (tpos < slen - 1) unpack8(*(const u32x4*)(zrw + (size_t)(row + 1) * 1792 + 1024 + c0), zn); else {
#pragma unroll
            for (int e = 0; e < 8; ++e) zn[e] = 0.f; }
        unpack8(*(const u32x4*)(g3 + (size_t)row * 512 + c0), g);
        const float bsum = bs[(size_t)row * 8 + head] + bs[((size_t)T + row) * 8 + head];
        float y[8], s = 0.f;
#pragma unroll
        for (int e = 0; e < 8; ++e) { y[e] = yf[e] + yb[e]; s += y[e]; }
        const float mu = sum8(s) * (1.f / 64.f); float q = 0.f;
#pragma unroll
        for (int e = 0; e < 8; ++e) { y[e] -= mu; q += y[e] * y[e]; }
        const float rs = rsqrtf(sum8(q) * (1.f / 64.f) + 64e-5f);
        float o[8];
#pragma unroll
        for (int e = 0; e < 8; ++e) { const float vv = z[e] + mp[e] * (zp[e] - z[e]) + mn[e] * (zn[e] - z[e]); o[e] = (y[e] * rs * lg[e] + lb[e] + bsum * vv) * g[e]; }
        asm volatile("" ::: "memory");
        *(u32x4*)(g3 + (size_t)row * 512 + c0) = pack8(o);
        const float* src = lat ? ((l == 0 ? p.in[I_X] : (const float*)p.out) + (size_t)row * 1024) : ((l == 0 ? p.in[I_CTX] : hc) + (size_t)(row - TL) * 1024);
        f32x4 x[4];
#pragma unroll
        for (int j = 0; j < 4; ++j) x[j] = *(const f32x4*)(src + 4 * lane + 256 * j);
        asm volatile("" ::: "memory");
        hx_from_row(p, l, v, x, lane, hx + (size_t)row * 1024);
    }
}

constexpr int SC_ARR = 0, SC_YL = 49152, SC_XS = 57344, SC_WT = 66560;
__device__ __forceinline__ void scan_chain(const Params& p, int l, int chain, unsigned char* lds) {
    const int tid = otid(), wave = tid >> 6, lane = tid & 63, hi = lane >> 5;
    const int b = chain >> 4, h = (chain >> 1) & 7, dir = chain & 1;
    const bf16_t* zrw = (const bf16_t*)(p.ws + WS_ZRW); bf16_t* yfb = (bf16_t*)(p.ws + WS_HX); float* bs = (float*)(p.ws + WS_BS);
    float* arr = (float*)(lds + SC_ARR); float* yl = (float*)(lds + SC_YL);
    unsigned char* xs = lds + SC_XS; unsigned char* wt = lds + SC_WT;
    { const float* wu = p.in[I_WUP] + ((size_t)(l * 2 + dir) * 64) * 512 + h * 64; const float* au = p.in[I_AUP] + ((size_t)(l * 2 + dir) * 64) * 512 + h * 64;
      for (int idx = tid; idx < 8192; idx += 512) { const int m = idx >> 12, i = (idx >> 6) & 63, j = idx & 63;
          const float v = (m ? au : wu)[(size_t)i * 512 + j]; *(bf16_t*)(wt + (m * 64 + j) * 144 + i * 2) = (bf16_t)f2bf(v); } }
    const int tt = tid >> 3, jg = tid & 7;
    const int ch0 = h * 64 + 8 * jg;
    const int colq[5] = {ch0, 512 + ch0, 1024 + ch0, 1536 + dir * 64 + 8 * jg, 1664 + dir * 64 + 8 * jg};
    float S[8];
#pragma unroll
    for (int e = 0; e < 8; ++e) S[e] = 0.f;
    const int rl = lane >> 3, cgp = lane & 7, srow = wave * 8 + rl;
    __syncthreads();
#pragma unroll 1
    for (int seg = 0; seg < 2; ++seg) {
        const int len = seg == 0 ? CTXL : SEQ; const size_t rbase = seg == 0 ? (size_t)TL + b * CTXL : (size_t)b * SEQ;
#pragma unroll 1
        for (int ci = 0; ci < len / 32; ++ci) {
            const int t0 = dir == 0 ? ci * 32 : len - 32 * (ci + 1);
            float rs_[8], ks_[8], vs_[8];
            if (tid < 256) {
                const int t = t0 + tt; const size_t row = rbase + t;
                float us[5][8];
#pragma unroll
                for (int qn = 0; qn < 5; ++qn) {
                    float z[8], zp[8], zn[8];
                    unpack8(*(const u32x4*)(zrw + row * 1792 + colq[qn]), z);
                    if (t > 0) unpack8(*(const u32x4*)(zrw + (row - 1) * 1792 + colq[qn]), zp); else {
#pragma unroll
                        for (int e = 0; e < 8; ++e) zp[e] = 0.f; }
                    if (t < len - 1) unpack8(*(const u32x4*)(zrw + (row + 1) * 1792 + colq[qn]), zn); else {
#pragma unroll
                        for (int e = 0; e < 8; ++e) zn[e] = 0.f; }
                    const float* mup = p.in[I_MU] + (size_t)(l * 2 + 0) * 1792 + colq[qn]; const float* mun = p.in[I_MU] + (size_t)(l * 2 + 1) * 1792 + colq[qn];
#pragma unroll
                    for (int e = 0; e < 8; ++e) us[qn][e] = z[e] + mup[e] * (zp[e] - z[e]) + mun[e] * (zn[e] - z[e]);
                }
#pragma unroll
                for (int e = 0; e < 8; ++e) { rs_[e] = us[0][e]; ks_[e] = us[1][e]; vs_[e] = us[2][e]; }
                float tw[8];
#pragma unroll
                for (int e = 0; e < 8; ++e) { const float ex = __expf(2.f * us[3][e]); tw[e] = 1.f - 2.f / (ex + 1.f); }
                *(u32x4*)(xs + (0 * 32 + tt) * 144 + jg * 16) = pack8(tw);
                *(u32x4*)(xs + (1 * 32 + tt) * 144 + jg * 16) = pack8(us[4]);
            }
            __syncthreads();
            if (wave >= 4) {
                const int m = wave & 1, nb = (wave >> 1) & 1;
                f32x16 acc = {};
#pragma unroll
                for (int ks = 0; ks < 4; ++ks) {
                    const bf16x8 A = *(const bf16x8*)(xs + (m * 32 + (lane & 31)) * 144 + (16 * ks + 8 * hi) * 2);
                    const bf16x8 B = *(const bf16x8*)(wt + (m * 64 + 32 * nb + (lane & 31)) * 144 + (16 * ks + 8 * hi) * 2);
                    acc = __builtin_amdgcn_mfma_f32_32x32x16_bf16(A, B, acc, 0, 0, 0);
                }
                float* dst = arr + (m == 0 ? 0 : 3) * 2048;
#pragma unroll
                for (int r = 0; r < 16; ++r) { const int trow = (r & 3) + 8 * (r >> 2) + 4 * hi; dst[trow * 64 + 32 * nb + (lane & 31)] = acc[r]; }
            }
            __syncthreads();
            if (tid < 256) {
                const int t = t0 + tt; const size_t row = rbase + t;
                float wl[8], al[8];
                { const f32x4 a0 = *(const f32x4*)(arr + 0 * 2048 + tt * 64 + 8 * jg), a1 = *(const f32x4*)(arr + 0 * 2048 + tt * 64 + 8 * jg + 4);
                  const f32x4 b0 = *(const f32x4*)(arr + 3 * 2048 + tt * 64 + 8 * jg), b1 = *(const f32x4*)(arr + 3 * 2048 + tt * 64 + 8 * jg + 4);
#pragma unroll
                  for (int e = 0; e < 4; ++e) { wl[e] = a0[e]; wl[4 + e] = a1[e]; al[e] = b0[e]; al[4 + e] = b1[e]; } }
                float dec[8], kd[8], av[8], bv[8], kk[8]; float n2 = 0.f, bon = 0.f;
#pragma unroll
                for (int e = 0; e < 8; ++e) {
                    const int ch = ch0 + e;
                    const float xw = p.in[I_W0][(l * 2 + dir) * 512 + ch] + wl[e];
                    const float sp = fmaxf(-xw, 0.f) + log1pf(__expf(-fabsf(xw)));
                    const float wlog = -sp - 0.5f;
                    dec[e] = __expf(-__expf(wlog));
                    const float a = 1.f / (1.f + __expf(-(p.in[I_A0][(l * 2 + dir) * 512 + ch] + al[e])));
                    kk[e] = ks_[e] * p.in[I_KK][l * 512 + ch]; n2 += kk[e] * kk[e];
                    kd[e] = ks_[e] * (1.f + (a - 1.f) * p.in[I_KA][l * 512 + ch]);
                    bon += rs_[e] * kd[e] * p.in[I_RK][l * 512 + ch];
                    av[e] = a;
                }
                n2 = sum8(n2); bon = sum8(bon);
                const float rn = 1.f / fmaxf(sqrtf(n2), 1e-12f);
#pragma unroll
                for (int e = 0; e < 8; ++e) { kk[e] *= rn; bv[e] = kk[e] * av[e]; kk[e] = -kk[e]; }
                float* a0p = arr + tt * 64 + 8 * jg;
                *(f32x4*)(a0p + 0 * 2048) = (f32x4){dec[0], dec[1], dec[2], dec[3]}; *(f32x4*)(a0p + 0 * 2048 + 4) = (f32x4){dec[4], dec[5], dec[6], dec[7]};
                *(f32x4*)(a0p + 1 * 2048) = (f32x4){kd[0], kd[1], kd[2], kd[3]};     *(f32x4*)(a0p + 1 * 2048 + 4) = (f32x4){kd[4], kd[5], kd[6], kd[7]};
                *(f32x4*)(a0p + 2 * 2048) = (f32x4){kk[0], kk[1], kk[2], kk[3]};     *(f32x4*)(a0p + 2 * 2048 + 4) = (f32x4){kk[4], kk[5], kk[6], kk[7]};
                *(f32x4*)(a0p + 3 * 2048) = (f32x4){bv[0], bv[1], bv[2], bv[3]};     *(f32x4*)(a0p + 3 * 2048 + 4) = (f32x4){bv[4], bv[5], bv[6], bv[7]};
                *(f32x4*)(a0p + 4 * 2048) = (f32x4){rs_[0], rs_[1], rs_[2], rs_[3]}; *(f32x4*)(a0p + 4 * 2048 + 4) = (f32x4){rs_[4], rs_[5], rs_[6], rs_[7]};
                *(f32x4*)(a0p + 5 * 2048) = (f32x4){vs_[0], vs_[1], vs_[2], vs_[3]}; *(f32x4*)(a0p + 5 * 2048 + 4) = (f32x4){vs_[4], vs_[5], vs_[6], vs_[7]};
                if (jg == 0) bs[((size_t)dir * T + row) * 8 + h] = bon;
            }
            __syncthreads();
#pragma unroll 1
            for (int s = 0; s < 32; ++s) {
                const int ts = dir == 0 ? s : 31 - s;
                const float* ap = arr + ts * 64 + 8 * cgp;
                const f32x4 w0 = *(const f32x4*)(ap), w1 = *(const f32x4*)(ap + 4);
                const f32x4 k0 = *(const f32x4*)(ap + 2048), k1 = *(const f32x4*)(ap + 2048 + 4);
                const f32x4 a0 = *(const f32x4*)(ap + 4096), a1 = *(const f32x4*)(ap + 4096 + 4);
                const f32x4 b0 = *(const f32x4*)(ap + 6144), b1 = *(const f32x4*)(ap + 6144 + 4);
                const f32x4 r0 = *(const f32x4*)(ap + 8192), r1 = *(const f32x4*)(ap + 8192 + 4);
                const float vi = arr[5 * 2048 + ts * 64 + srow];
                float sa = (S[0] * a0[0] + S[1] * a0[1]) + (S[2] * a0[2] + S[3] * a0[3]) + (S[4] * a1[0] + S[5] * a1[1]) + (S[6] * a1[2] + S[7] * a1[3]);
                sa = sum8(sa);
#pragma unroll
                for (int e = 0; e < 4; ++e) { S[e] = S[e] * w0[e] + sa * b0[e] + vi * k0[e]; S[4 + e] = S[4 + e] * w1[e] + sa * b1[e] + vi * k1[e]; }
                float y = (S[0] * r0[0] + S[1] * r0[1]) + (S[2] * r0[2] + S[3] * r0[3]) + (S[4] * r1[0] + S[5] * r1[1]) + (S[6] * r1[2] + S[7] * r1[3]);
                y = sum8(y);
                if (cgp == 0) yl[ts * 64 + srow] = y;
            }
            __syncthreads();
            if (tid < 256) {
                const size_t row = rbase + t0 + tt;
                const f32x4 y0 = *(const f32x4*)(yl + tt * 64 + 8 * jg), y1 = *(const f32x4*)(yl + tt * 64 + 8 * jg + 4);
                u32x4 o; o.x = pk2(y0[0], y0[1]); o.y = pk2(y0[2], y0[3]); o.z = pk2(y1[0], y1[1]); o.w = pk2(y1[2], y1[3]);
                *(u32x4*)(yfb + row * 1024 + dir * 512 + ch0) = o;
            }
        }
    }
    __syncthreads();
}

__device__ __forceinline__ s16x4 tr_read(const unsigned char* pgen) {
    return __builtin_bit_cast(s16x4, __builtin_amdgcn_ds_read_tr16_b64_v4i16((LAS s16x4*)(uintptr_t)(unsigned)(uintptr_t)pgen));
}
template <int KW, int DV, bool NA>
__device__ __forceinline__ void attn_loop(unsigned char* lds, const bf16_t* Kg, const bf16_t* Vg, int pitch,
                                          int n1, size_t base1, int ntile, size_t base2,
                                          const bf16x8 (&qf)[4], int kcoff, int act_lo, int act_hi,
                                          int na_r, int na_c, int na_row0, const float* rpbs,
                                          f32x16 (&o)[DV / 32], float& l_out) {
    constexpr int KSTR = KW * 2 + 16, VSTR = DV * 2 + 16, KCH = KW / 8, VCH = DV / 8, NK = KW / 64, NV = DV / 64;
    unsigned char* Kt = lds; unsigned char* Vt = lds + 64 * KSTR;
    const int tid = otid(), lane = tid & 63, q32 = lane & 31, hi = lane >> 5;
    u32x4 kreg[NK], vreg[NV];
    auto rowbase = [&](int i) -> size_t { return i < n1 ? base1 + (size_t)64 * i : base2 + (size_t)64 * (i - n1); };
    auto prefetch = [&](int i) {
        const size_t rb = rowbase(i);
#pragma unroll
        for (int e = 0; e < NK; ++e) { const int c = tid + 512 * e; kreg[e] = *(const u32x4*)(Kg + (rb + c / KCH) * pitch + (c % KCH) * 8); }
#pragma unroll
        for (int e = 0; e < NV; ++e) { const int c = tid + 512 * e; vreg[e] = *(const u32x4*)(Vg + (rb + c / VCH) * pitch + (c % VCH) * 8); }
    };
    float m_run = -INFINITY, l_run = 0.f;
#pragma unroll
    for (int d = 0; d < DV / 32; ++d) o[d] = (f32x16){};
    prefetch(0);
#pragma unroll 1
    for (int i = 0; i < ntile; ++i) {
        __syncthreads();
#pragma unroll
        for (int e = 0; e < NK; ++e) { const int c = tid + 512 * e; *(u32x4*)(Kt + (c / KCH) * KSTR + (c % KCH) * 16) = kreg[e]; }
#pragma unroll
        for (int e = 0; e < NV; ++e) { const int c = tid + 512 * e; *(u32x4*)(Vt + (c / VCH) * VSTR + (c % VCH) * 16) = vreg[e]; }
        __syncthreads();
        if (i + 1 < ntile) prefetch(i + 1);
        const bool active = (i >= n1) || (i >= act_lo && i < act_hi);
        if (active) {
            f32x16 p0 = {}, p1 = {};
#pragma unroll
            for (int d0 = 0; d0 < 4; ++d0) {
                const bf16x8 a0 = *(const bf16x8*)(Kt + q32 * KSTR + (kcoff + 16 * d0 + 8 * hi) * 2);
                const bf16x8 a1 = *(const bf16x8*)(Kt + (32 + q32) * KSTR + (kcoff + 16 * d0 + 8 * hi) * 2);
                p0 = __builtin_amdgcn_mfma_f32_32x32x16_bf16(a0, qf[d0], p0, 0, 0, 0);
                p1 = __builtin_amdgcn_mfma_f32_32x32x16_bf16(a1, qf[d0], p1, 0, 0, 0);
            }
            if (NA && i < n1) {
                const int kr = na_row0 + i, dr = kr - na_r + 7;
                const int cs = min(max(na_c - 8, 0), 48);
                const float* rb = rpbs + dr * 31 - na_c + 15;
#pragma unroll
                for (int r = 0; r < 16; ++r) {
                    const int kc0 = (r & 3) + 8 * (r >> 2) + 4 * hi, kc1 = kc0 + 32;
                    const bool ok0 = (kc0 >= cs) && (kc0 < cs + 16), ok1 = (kc1 >= cs) && (kc1 < cs + 16);
                    p0[r] = ok0 ? p0[r] + rb[kc0] : -1e30f;
                    p1[r] = ok1 ? p1[r] + rb[kc1] : -1e30f;
                }
            }
            float mx = fmaxf(p0[0], p1[0]);
#pragma unroll
            for (int r = 1; r < 16; ++r) mx = fmaxf(mx, fmaxf(p0[r], p1[r]));
            mx = fmaxf(mx, __shfl_xor(mx, 32));
            const float mnew = fmaxf(m_run, mx);
            const float f = __builtin_amdgcn_exp2f(m_run - mnew);
            m_run = mnew;
            float ps = 0.f;
#pragma unroll
            for (int r = 0; r < 16; ++r) { p0[r] = __builtin_amdgcn_exp2f(p0[r] - mnew); p1[r] = __builtin_amdgcn_exp2f(p1[r] - mnew); ps += p0[r] + p1[r]; }
            l_run = l_run * f + ps;
#pragma unroll
            for (int d = 0; d < DV / 32; ++d)
#pragma unroll
                for (int r = 0; r < 16; ++r) o[d][r] *= f;
            u32x4 pw[4];
            pw[0] = (u32x4){pk2(p0[0], p0[1]), pk2(p0[2], p0[3]), pk2(p0[4], p0[5]), pk2(p0[6], p0[7])};
            pw[1] = (u32x4){pk2(p0[8], p0[9]), pk2(p0[10], p0[11]), pk2(p0[12], p0[13]), pk2(p0[14], p0[15])};
            pw[2] = (u32x4){pk2(p1[0], p1[1]), pk2(p1[2], p1[3]), pk2(p1[4], p1[5]), pk2(p1[6], p1[7])};
            pw[3] = (u32x4){pk2(p1[8], p1[9]), pk2(p1[10], p1[11]), pk2(p1[12], p1[13]), pk2(p1[14], p1[15])};
            const unsigned char* vb = Vt + (4 * hi + ((lane & 15) >> 2)) * VSTR + (16 * ((lane >> 4) & 1) + 4 * (lane & 3)) * 2;
#pragma unroll
            for (int d = 0; d < DV / 32; ++d) {
                __builtin_amdgcn_sched_barrier(0);
#pragma unroll
                for (int ks = 0; ks < 4; ++ks) {
                    const s16x4 lo = tr_read(vb + (16 * ks) * VSTR + 64 * d), hh = tr_read(vb + (16 * ks + 8) * VSTR + 64 * d);
                    const bf16x8 vf = (bf16x8){lo[0], lo[1], lo[2], lo[3], hh[0], hh[1], hh[2], hh[3]};
                    o[d] = __builtin_amdgcn_mfma_f32_32x32x16_bf16(vf, __builtin_bit_cast(bf16x8, pw[ks]), o[d], 0, 0, 0);
                }
            }
        }
    }
    l_out = l_run + __shfl_xor(l_run, 32);
}

constexpr int AT_X1 = 36864, AT_RPB = 102400, AT_SLOT = 104448;
__device__ __forceinline__ void diff_unit(const Params& p, int l, int b, int h, size_t qrow0, int tile_lo, unsigned char* lds) {
    const int tid = otid(), wave = tid >> 6, lane = tid & 63, q32 = lane & 31, hi = lane >> 5, qg = wave >> 1, m = wave & 1;
    const bf16_t* dfq = (const bf16_t*)(p.ws + WS_DFQ); bf16_t* gout = (bf16_t*)(p.ws + WS_G3) + (size_t)2 * T * 512;
    const size_t qrow = qrow0 + qg * 32 + q32;
    bf16x8 qf[4];
#pragma unroll
    for (int d0 = 0; d0 < 4; ++d0) qf[d0] = *(const bf16x8*)(dfq + qrow * 1536 + h * 128 + m * 64 + 16 * d0 + 8 * hi);
    f32x16 o[4]; float lsum;
    const int n1 = 64 - tile_lo;
    attn_loop<128, 128, false>(lds, dfq + 512 + h * 128, dfq + 1024 + h * 128, 1536, n1, (size_t)b * SEQ, n1 + 4, (size_t)TL + b * CTXL,
                               qf, m * 64, 0, n1, 0, 0, 0, nullptr, o, lsum);
    const float il = 1.f / lsum;
    float* x1 = (float*)(lds + AT_X1) + qg * 4096;
    if (m == 1) {
#pragma unroll
        for (int d = 0; d < 4; ++d)
#pragma unroll
            for (int r = 0; r < 16; ++r) x1[(32 * d + (r & 3) + 8 * (r >> 2) + 4 * hi) * 32 + q32] = o[d][r] * il;
    }
    __syncthreads();
    if (m == 0) {
        float lam;
        { const float a = p.in[I_LAMQ][(l * 2 + 0) * 64 + lane] * p.in[I_LAMK][(l * 2 + 0) * 64 + lane], c = p.in[I_LAMQ][(l * 2 + 1) * 64 + lane] * p.in[I_LAMK][(l * 2 + 1) * 64 + lane];
          const float li = 0.8f - 0.6f * __expf(-0.3f * (float)l); lam = __expf(wave_sum(a)) - __expf(wave_sum(c)) + li; }
        const float li = 0.8f - 0.6f * __expf(-0.3f * (float)l);
        float ss = 0.f;
#pragma unroll
        for (int d = 0; d < 4; ++d)
#pragma unroll
            for (int r = 0; r < 16; ++r) { const float v = o[d][r] * il - lam * x1[(32 * d + (r & 3) + 8 * (r >> 2) + 4 * hi) * 32 + q32]; o[d][r] = v; ss += v * v; }
        ss += __shfl_xor(ss, 32);
        const float rn = rsqrtf(ss * (1.f / 128.f) + 1e-5f) * (1.f - li);
#pragma unroll
        for (int d = 0; d < 4; ++d)
#pragma unroll
            for (int g = 0; g < 4; ++g) {
                const int dd = 32 * d + 8 * g + 4 * hi;
                bf16_t* gp = gout + qrow * 512 + h * 128 + dd;
                const u32x2 gw = *(const u32x2*)gp;
                const f32x4 sg = *(const f32x4*)(p.in[I_SUBLN] + l * 128 + dd);
                const float v0 = o[d][4 * g + 0] * rn * sg[0] * bf2f(gw.x & 0xffffu), v1 = o[d][4 * g + 1] * rn * sg[1] * bf2f(gw.x >> 16);
                const float v2 = o[d][4 * g + 2] * rn * sg[2] * bf2f(gw.y & 0xffffu), v3 = o[d][4 * g + 3] * rn * sg[3] * bf2f(gw.y >> 16);
                u32x2 ow; ow.x = pk2(v0, v1); ow.y = pk2(v2, v3); *(u32x2*)gp = ow;
            }
    }
    __syncthreads();
}
__device__ __forceinline__ void na_unit(const Params& p, int l, int b, int h, int rb4, bool ctxq, unsigned char* lds) {
    const int tid = otid(), wave = tid >> 6, lane = tid & 63, q32 = lane & 31, hi = lane >> 5;
    const bf16_t* naq = (const bf16_t*)(p.ws + WS_NAQ); bf16_t* gout = (bf16_t*)(p.ws + WS_G3) + (size_t)T * 512;
    float* rpbs = (float*)(lds + AT_RPB);
    size_t qrow; int n1, act_lo = 0, act_hi = 0, na_r = 0, na_c = 0, row_lo = 0;
    if (!ctxq) {
        const int R0 = 4 * rb4, r = R0 + (wave >> 1), c = 32 * (wave & 1) + q32;
        row_lo = min(max(R0 - 4, 0), 56); const int row_hi = min(max(R0 + 3 - 4, 0), 56) + 7;
        n1 = row_hi - row_lo + 1;
        const int rs = min(max(r - 4, 0), 56); act_lo = rs - row_lo; act_hi = act_lo + 8; na_r = r; na_c = c;
        qrow = (size_t)b * SEQ + r * 64 + c;
        for (int i = tid; i < 15 * 31; i += 512) rpbs[i] = p.in[I_RPB][((size_t)(l * 8 + h) * 15) * 31 + i] * LOG2E;
    } else { n1 = 0; qrow = (size_t)TL + b * CTXL + wave * 32 + q32; }
    bf16x8 qf[4];
#pragma unroll
    for (int d0 = 0; d0 < 4; ++d0) qf[d0] = *(const bf16x8*)(naq + qrow * 1536 + h * 64 + 16 * d0 + 8 * hi);
    f32x16 o[2]; float lsum;
    attn_loop<64, 64, true>(lds, naq + 512 + h * 64, naq + 1024 + h * 64, 1536, n1, (size_t)b * SEQ + (size_t)row_lo * 64, n1 + 4, (size_t)TL + b * CTXL,
                            qf, 0, act_lo, act_hi, na_r, na_c, row_lo, rpbs, o, lsum);
    const float il = 1.f / lsum;
#pragma unroll
    for (int d = 0; d < 2; ++d)
#pragma unroll
        for (int g = 0; g < 4; ++g) {
            const int dd = 32 * d + 8 * g + 4 * hi;
            bf16_t* gp = gout + qrow * 512 + h * 64 + dd;
            const u32x2 gw = *(const u32x2*)gp;
            const float v0 = o[d][4 * g + 0] * il * bf2f(gw.x & 0xffffu), v1 = o[d][4 * g + 1] * il * bf2f(gw.x >> 16);
            const float v2 = o[d][4 * g + 2] * il * bf2f(gw.y & 0xffffu), v3 = o[d][4 * g + 3] * il * bf2f(gw.y >> 16);
            u32x2 ow; ow.x = pk2(v0, v1); ow.y = pk2(v2, v3); *(u32x2*)gp = ow;
        }
    __syncthreads();
}

constexpr int NU_DIFF = NB * 4 * 32, NU_NA = NB * 8 * 16, NU_DC = NB * 4 * 2, NU_NC = NB * 8, NU_ALL = NU_DIFF + NU_NA + NU_DC + NU_NC;
__device__ __forceinline__ void phase_branches(const Params& p, int l, unsigned char* lds) {
    #ifndef NO_SCAN
    if (blockIdx.x < 128) scan_chain(p, l, blockIdx.x, lds);
#endif
    unsigned* ctr = (unsigned*)(p.ws + WS_CTL) + 64 * (l + 1);
    volatile int* slot = (volatile int*)(lds + AT_SLOT);
    for (;;) {
        __syncthreads();
        if (threadIdx.x == 0) *slot = (int)atomicAdd(ctr, 1u);
        __syncthreads();
        int u = *slot;
        if (u >= NU_ALL) break;
        if (u < NU_DIFF) { const int b = u >> 7, h = (u >> 5) & 3, qb = u & 31; diff_unit(p, l, b, h, (size_t)b * SEQ + qb * 128, 0, lds); continue; }
        u -= NU_DIFF;
        if (u < NU_NA) { const int b = u >> 7, h = (u >> 4) & 7, rb4 = u & 15; na_unit(p, l, b, h, rb4, false, lds); continue; }
        u -= NU_NA;
        if (u < NU_DC) { const int b = u >> 3, h = (u >> 1) & 3, qb = u & 1; diff_unit(p, l, b, h, (size_t)TL + b * CTXL + qb * 128, 64, lds); continue; }
        u -= NU_DC;
        { const int b = u >> 3, h = u & 7; na_unit(p, l, b, h, 0, true, lds); }
    }
}

__device__ __forceinline__ void run_gemm(const Params& p, int kind, unsigned char* lds) {
    bf16_t* hx = (bf16_t*)(p.ws + WS_HX); bf16_t* win = (bf16_t*)(p.ws + WS_WIN);
    Epi E; E.mode = kind; E.zrw = (bf16_t*)(p.ws + WS_ZRW); E.naq = (bf16_t*)(p.ws + WS_NAQ); E.dfq = (bf16_t*)(p.ws + WS_DFQ); E.g3 = (bf16_t*)(p.ws + WS_G3);
    E.sg = (bf16_t*)(p.ws + WS_SG); E.mout = (bf16_t*)(p.ws + WS_M); E.mpart = (float*)(p.ws + WS_MPART); E.ybuf = (float*)(p.ws + WS_YBUF); E.rope = (const f32x2*)(p.ws + WS_ROPE);
    pg8::Gemm g; Sched S; S.mode = 0; S.G = gridDim.x; S.c = blockIdx.x;
    if (kind == 0) { g = pg8::Gemm{hx, win, T, NMAIN, 1024}; S.so.init(T, NMAIN, gridDim.x, blockIdx.x); }
    else if (kind == 1) { g = pg8::Gemm{hx, win + (size_t)NMAIN * 1024, T, 3072, 1024}; S.so.init(T, 3072, gridDim.x, blockIdx.x); }
    else if (kind == 2) { g = pg8::Gemm{(const bf16_t*)(p.ws + WS_G3), (const bf16_t*)(p.ws + WS_WBR), 3 * T, 3072, 512}; S.mode = 1; S.so.init(T, 1024, gridDim.x, blockIdx.x); }
    else { g = pg8::Gemm{(const bf16_t*)(p.ws + WS_M), (const bf16_t*)(p.ws + WS_WOUT), T, 1024, 1024}; S.so.init(T, 1024, gridDim.x, blockIdx.x); }
    pg8::gemm_phase<Epi, Sched, true, true>((PG8_LAS unsigned char*)lds, g, S, E);
}

__global__ void __launch_bounds__(512, 2) mega_fwd(Params p) {
    extern __shared__ __attribute__((aligned(16))) unsigned char lds[];
    cg::grid_group grid = cg::this_grid();
    for (int ph = p.ph_lo; ph < p.ph_hi; ++ph) {
        if (ph > p.ph_lo) grid.sync();
        if (ph == 0) {
#ifndef NO_PRO
 phase_prologue(p, lds);
#endif
 continue; }
        if (ph == NPHASE - 1) { phase_rowpass(p, DEPTH); continue; }
        const int l = (ph - 1) / 7, s = (ph - 1) % 7;
        if (s == 0) {
#ifndef NO_ROW
 if (l > 0) convert_weights(p, l, lds); phase_rowpass(p, l);
#endif
 }
        else if (s == 1) {
#ifndef NO_GEMM
 run_gemm(p, 0, lds);
#endif
 }
        else if (s == 2) {
#ifndef NO_BR
 phase_branches(p, l, lds);
#endif
 }
        else if (s == 3) {
#ifndef NO_RO
 phase_readout(p, l);
#endif
 }
        else {
#ifndef NO_GEMM
 run_gemm(p, s - 3, lds);
#endif
 }
        __syncthreads();
    }
}

#ifndef N_LAUNCH_MODE
#define N_LAUNCH_MODE 0
#endif
extern "C" void kernel_launch(void* const* d_in, const int* in_sizes, int n_in, void* d_out, int out_size, void* d_ws, size_t ws_size, hipStream_t stream) {
    static int grid = 0;
    if (grid == 0) {
        if (n_in != 25 || out_size != TL * DM || ws_size < WS_END) { fprintf(stderr, "kernel_launch: unexpected sizes n_in %d out %d ws %zu\n", n_in, out_size, ws_size); grid = -1; return; }
        int dev = 0, cus = 0, per_cu = 0;
        hipGetDevice(&dev); hipDeviceGetAttribute(&cus, hipDeviceAttributeMultiprocessorCount, dev);
        hipFuncSetAttribute((const void*)mega_fwd, hipFuncAttributeMaxDynamicSharedMemorySize, LDS_BYTES);
        hipOccupancyMaxActiveBlocksPerMultiprocessor(&per_cu, (const void*)mega_fwd, 512, LDS_BYTES);
        (void)hipGetLastError();
        if (per_cu < 1) per_cu = 1;
        grid = cus;
        if (grid > cus * per_cu) grid = cus * per_cu;
    }
    if (grid < 0) return;
    hipMemsetAsync((char*)d_ws + WS_CTL, 0, 4096, stream);
    Params a{};
    for (int i = 0; i < 25; ++i) a.in[i] = (const float*)d_in[i];
    a.out = (float*)d_out; a.ws = (unsigned char*)d_ws;
#if N_LAUNCH_MODE == 1
    a.ph_lo = 0; a.ph_hi = NPHASE;
    void* args[] = {&a};
    hipError_t e = hipLaunchCooperativeKernel((const void*)mega_fwd, dim3(grid), dim3(512), args, LDS_BYTES, stream);
    if (e != hipSuccess) fprintf(stderr, "cooperative launch failed: %s (grid %d)\n", hipGetErrorString(e), grid);
#else
    for (int ph = 0; ph < NPHASE; ++ph) { a.ph_lo = ph; a.ph_hi = ph + 1; hipLaunchKernelGGL(mega_fwd, dim3(grid), dim3(512), LDS_BYTES, stream, a); }
#endif
}
```

```cpp
#include <hip/hip_runtime.h>
#include <hip/hip_cooperative_groups.h>
#include <cstdio>
#include <cstdint>
namespace cg = cooperative_groups;
__device__ __forceinline__ int otid() { int t = threadIdx.x; asm volatile("" : "+v"(t)); return t; }
namespace pg8 {
#define PG8_LAS __attribute__((address_space(3)))
typedef unsigned short bf16_t;
typedef short bf16x8 __attribute__((ext_vector_type(8)));
typedef float f32x4 __attribute__((ext_vector_type(4)));
typedef unsigned u32x4 __attribute__((ext_vector_type(4)));
constexpr int BM = 256, BK = 64, HALF = 128, HTB = HALF * BK * 2  , STAGE_BYTES = 8 * HTB, NXCD = 8, WGM = 8;

__host__ __device__ __forceinline__ int lds_byte(int r, int c) { const int st = (r >> 4) * 2 + (c >> 5), rr = r & 15, cc = c & 31, ob = rr * 64 + cc * 2; return st * 1024 + (ob ^ (((ob >> 9) & 1) << 5)); }
__host__ __device__ __forceinline__ void stage_rc(int b, int& R, int& C) { const int st = b / 1024, sb = b % 1024, swz = sb ^ (((sb >> 9) & 1) << 5); R = (st >> 1) * 16 + swz / 64; C = (st & 1) * 32 + (swz % 64) / 2; }
__host__ __device__ __forceinline__ int perm32(int rho) { const int n = rho >> 4, i = rho & 15; return 8 * (i >> 2) + 4 * n + (i & 3); }

struct Unit { int pm, pn; };
struct Gemm { const bf16_t* A; const bf16_t* Bt; int M, N, K; };

struct StaticOrder {
    int nM, nN, nwg, G, c;
    __host__ __device__ void init(int M, int N, int G_, int c_) { nM = M / BM; nN = N / BM; nwg = nM * nN; G = G_; c = c_; }
    __host__ __device__ bool next(int i, Unit& u) const {
        const long L = (long)i * G + c; if (L >= nwg) return false;
        int wgid = (int)L; { const int q = nwg / NXCD, r = nwg % NXCD, xcd = wgid % NXCD, off = wgid / NXCD; wgid = (xcd < r ? xcd * (q + 1) : r * (q + 1) + (xcd - r) * q) + off; }
        const int nig = WGM * nN, gid = wgid / nig, fm = gid * WGM, gsz = (nM - fm) < WGM ? (nM - fm) : WGM;
        u.pm = fm + ((wgid % nig) % gsz); u.pn = (wgid % nig) / gsz; return true;
    }
    __device__ __forceinline__ void a_ready(const Unit&) const {}
    __device__ __forceinline__ void done(const Unit&) const {}
};

template <class Epi, class Sched, bool ALIGN_EPI = false, bool SP2 = false>
__device__ __forceinline__ void gemm_phase(PG8_LAS unsigned char* lds, const Gemm g, const Sched& S, const Epi& E) {
    const int tid = otid(), wid = __builtin_amdgcn_readfirstlane(tid >> 6), lane = tid & 63, wr = wid >> 2, wc = wid & 3, fr = lane & 15, fq = lane >> 4;
    const int K = g.K, nt = K / BK;
    unsigned voffA[2], voffB[2];
#pragma unroll
    for (int i = 0; i < 2; ++i) { int R, C; stage_rc(tid * 16 + i * 8192, R, C); const int Rb = Epi::PERM ? ((R & ~31) + perm32(R & 31)) : R;
        voffA[i] = (unsigned)(R * K + C) * 2u; voffB[i] = (unsigned)(Rb * K + C) * 2u; }
    const size_t kstep = (size_t)(BK * 2);
    const size_t hstep = (size_t)HALF * K * 2;
    const size_t tstep = 2 * hstep;
    const unsigned ldsw = (unsigned)wid * 1024u;
    const int aoff = lds_byte(wr * 64 + fr, fq * 8), boff = lds_byte(wc * 32 + fr, fq * 8);
#define PG8_SA(b, h) (((b) * 2 + (h)) * HTB)
#define PG8_SB(b, h) ((4 + (b) * 2 + (h)) * HTB)
#define PG8_STAGE(bufoff, gbase, voff) do { _Pragma("unroll") for (int _i = 0; _i < 2; ++_i) \
        __builtin_amdgcn_global_load_lds((const unsigned*)((const char*)(gbase) + (voff)[_i]), (PG8_LAS unsigned*)(lds + (bufoff) + ldsw + _i * 8192), 16, 0, 0); } while (0)
#define PG8_LDA(dst, b, h) do { _Pragma("unroll") for (int m = 0; m < 4; ++m) _Pragma("unroll") for (int k = 0; k < 2; ++k) dst[m][k] = *(const PG8_LAS bf16x8*)(lds + PG8_SA(b, h) + aoff + m * 2048 + k * 1024); } while (0)
#define PG8_LDB(dst, b, h) do { _Pragma("unroll") for (int n = 0; n < 2; ++n) _Pragma("unroll") for (int k = 0; k < 2; ++k) dst[n][k] = *(const PG8_LAS bf16x8*)(lds + PG8_SB(b, h) + boff + n * 2048 + k * 1024); } while (0)
#define PG8_MMA(ai, bj, At, Bt) do { __builtin_amdgcn_s_setprio(1); _Pragma("unroll") for (int m = 0; m < 4; ++m) _Pragma("unroll") for (int n = 0; n < 2; ++n) _Pragma("unroll") for (int k = 0; k < 2; ++k) \
        acc[ai][bj][m][n] = __builtin_amdgcn_mfma_f32_16x16x32_bf16(Bt[n][k], At[m][k], acc[ai][bj][m][n], 0, 0, 0); __builtin_amdgcn_s_setprio(0); } while (0)
#define PG8_WAIT_V(n) asm volatile("s_waitcnt vmcnt(" #n ")" ::: "memory")
#define PG8_WAIT_L(n) asm volatile("s_waitcnt lgkmcnt(" #n ")" ::: "memory")
#define PG8_BAR __builtin_amdgcn_s_barrier()
#define PG8_SCHED __builtin_amdgcn_sched_barrier(0)
    Unit cur, nxt; int ui = 0;
    if (!S.next(0, cur)) return;
    f32x4 acc[2][2][4][2];
#pragma unroll
    for (int a = 0; a < 2; ++a)
#pragma unroll
        for (int b = 0; b < 2; ++b)
#pragma unroll
            for (int m = 0; m < 4; ++m)
#pragma unroll
                for (int n = 0; n < 2; ++n) acc[a][b][m][n] = (f32x4){0.f, 0.f, 0.f, 0.f};
    bf16x8 At[4][2], B0[2][2], B1[2][2];
    const char* cA = (const char*)g.A + (size_t)cur.pm * tstep; const char* cB = (const char*)g.Bt + (size_t)cur.pn * tstep;
    S.a_ready(cur);
    if constexpr (SP2) {
        PG8_STAGE(PG8_SB(0, 0), cB, voffB); PG8_STAGE(PG8_SB(0, 1), cB + hstep, voffB); PG8_STAGE(PG8_SA(0, 0), cA, voffA); PG8_STAGE(PG8_SA(0, 1), cA + hstep, voffA);
        if (wr == 1) PG8_BAR;
        PG8_WAIT_V(2); PG8_BAR;
        PG8_STAGE(PG8_SB(1, 0), cB + kstep, voffB); PG8_STAGE(PG8_SA(1, 0), cA + kstep, voffA); PG8_STAGE(PG8_SB(1, 1), cB + hstep + kstep, voffB);
        PG8_WAIT_V(6); PG8_BAR;
    } else {
        PG8_STAGE(PG8_SB(0, 0), cB, voffB); PG8_STAGE(PG8_SA(0, 0), cA, voffA); PG8_STAGE(PG8_SB(0, 1), cB + hstep, voffB); PG8_STAGE(PG8_SA(0, 1), cA + hstep, voffA);
        if (wr == 1) PG8_BAR;
        PG8_WAIT_V(4); PG8_BAR;
        PG8_STAGE(PG8_SB(1, 0), cB + kstep, voffB); PG8_STAGE(PG8_SA(1, 0), cA + kstep, voffA); PG8_STAGE(PG8_SB(1, 1), cB + hstep + kstep, voffB);
        PG8_WAIT_V(6); PG8_BAR;
    }
    for (;;) {
        const bool has_next = S.next(ui + 1, nxt);
        const char* nA = has_next ? (const char*)g.A + (size_t)nxt.pm * tstep : cA; const char* nB = has_next ? (const char*)g.Bt + (size_t)nxt.pn * tstep : cB;
        for (int t = 0; t < nt; t += 2) {
            const bool last = (t == nt - 2);
            const char* a1 = cA + (size_t)(t + 1) * kstep;
            const char* a2 = last ? nA : cA + (size_t)(t + 2) * kstep; const char* b2 = last ? nB : cB + (size_t)(t + 2) * kstep;
            const char* a3 = a2 + kstep; const char* b3 = b2 + kstep;
            if (last && has_next) S.a_ready(nxt);
            if constexpr (SP2) {
            PG8_LDB(B0, 0, 0); PG8_LDB(B1, 0, 1); PG8_SCHED; PG8_LDA(At, 0, 0); PG8_STAGE(PG8_SA(1, 1), a1 + hstep, voffA);
            PG8_WAIT_V(8); PG8_WAIT_L(0); PG8_BAR; PG8_MMA(0, 0, At, B0); PG8_MMA(0, 1, At, B1); PG8_BAR; PG8_SCHED;
            PG8_LDA(At, 0, 1); PG8_STAGE(PG8_SB(0, 0), b2, voffB); PG8_STAGE(PG8_SB(0, 1), b2 + hstep, voffB); PG8_STAGE(PG8_SA(0, 0), a2, voffA);
            PG8_WAIT_V(8); PG8_WAIT_L(0); PG8_BAR; PG8_MMA(1, 0, At, B0); PG8_MMA(1, 1, At, B1); PG8_BAR; PG8_SCHED;
            PG8_LDB(B0, 1, 0); PG8_LDB(B1, 1, 1); PG8_SCHED; PG8_LDA(At, 1, 0); PG8_STAGE(PG8_SA(0, 1), a2 + hstep, voffA);
            PG8_WAIT_V(8); PG8_WAIT_L(0); PG8_BAR; PG8_MMA(0, 0, At, B0); PG8_MMA(0, 1, At, B1); PG8_BAR; PG8_SCHED;
            PG8_LDA(At, 1, 1); PG8_STAGE(PG8_SB(1, 0), b3, voffB); PG8_STAGE(PG8_SB(1, 1), b3 + hstep, voffB); PG8_STAGE(PG8_SA(1, 0), a3, voffA);
            PG8_WAIT_V(8); PG8_WAIT_L(0); PG8_BAR; PG8_MMA(1, 0, At, B0); PG8_MMA(1, 1, At, B1); PG8_BAR; PG8_SCHED;
            } else {
            PG8_LDB(B0, 0, 0); PG8_SCHED; PG8_LDA(At, 0, 0); PG8_STAGE(PG8_SA(1, 1), a1 + hstep, voffA);
            PG8_WAIT_L(8); PG8_BAR; PG8_WAIT_L(0); PG8_MMA(0, 0, At, B0); PG8_BAR; PG8_SCHED;
            PG8_LDB(B1, 0, 1); PG8_STAGE(PG8_SB(0, 0), b2, voffB);
            PG8_BAR; PG8_WAIT_L(0); PG8_MMA(0, 1, At, B1); PG8_BAR;
            PG8_LDA(At, 0, 1); PG8_STAGE(PG8_SA(0, 0), a2, voffA);
            PG8_BAR; PG8_WAIT_L(0); PG8_MMA(1, 0, At, B0); PG8_BAR; PG8_SCHED;
            PG8_STAGE(PG8_SB(0, 1), b2 + hstep, voffB);
            PG8_WAIT_V(6); PG8_BAR; PG8_MMA(1, 1, At, B1); PG8_BAR;
            PG8_LDB(B0, 1, 0); PG8_SCHED; PG8_LDA(At, 1, 0); PG8_STAGE(PG8_SA(0, 1), a2 + hstep, voffA);
            PG8_WAIT_L(8); PG8_BAR; PG8_WAIT_L(0); PG8_MMA(0, 0, At, B0); PG8_BAR; PG8_SCHED;
            PG8_LDB(B1, 1, 1); PG8_STAGE(PG8_SB(1, 0), b3, voffB);
            PG8_BAR; PG8_WAIT_L(0); PG8_MMA(0, 1, At, B1); PG8_BAR;
            PG8_LDA(At, 1, 1); PG8_STAGE(PG8_SA(1, 0), a3, voffA);
            PG8_BAR; PG8_WAIT_L(0); PG8_MMA(1, 0, At, B0); PG8_BAR; PG8_SCHED;
            PG8_STAGE(PG8_SB(1, 1), b3 + hstep, voffB);
            PG8_WAIT_V(6); PG8_BAR; PG8_MMA(1, 1, At, B1); PG8_BAR;
            }
        }
        if constexpr (ALIGN_EPI) { if (wr == 0) PG8_BAR; }
        if constexpr (!Epi::AFTER_DRAIN) { E(acc, cur, wr, wc, fr, fq); S.done(cur); }
        if (!has_next) break;
#pragma unroll
        for (int a = 0; a < 2; ++a)
#pragma unroll
            for (int b = 0; b < 2; ++b)
#pragma unroll
                for (int m = 0; m < 4; ++m)
#pragma unroll
                    for (int n = 0; n < 2; ++n) acc[a][b][m][n] = (f32x4){0.f, 0.f, 0.f, 0.f};
        cur = nxt; cA = nA; cB = nB; ++ui;
        if constexpr (ALIGN_EPI) { if (wr == 1) PG8_BAR; }
    }
    PG8_WAIT_V(0);
    if constexpr (!ALIGN_EPI) { if (wr == 0) PG8_BAR; }
    PG8_BAR;
    if constexpr (Epi::AFTER_DRAIN) { E.fused(acc, cur, wr, wc, fr, fq, lds, wid, lane); S.done(cur); }
#undef PG8_SA
#undef PG8_SB
#undef PG8_STAGE
#undef PG8_LDA
#undef PG8_LDB
#undef PG8_MMA
#undef PG8_WAIT_V
#undef PG8_WAIT_L
#undef PG8_BAR
#undef PG8_SCHED
}
}

#define LAS __attribute__((address_space(3)))
typedef unsigned short bf16_t;
typedef short bf16x8 __attribute__((ext_vector_type(8)));
typedef short s16x4 __attribute__((ext_vector_type(4)));
typedef float f32x4 __attribute__((ext_vector_type(4)));
typedef float f32x2 __attribute__((ext_vector_type(2)));
typedef float f32x16 __attribute__((ext_vector_type(16)));
typedef unsigned u32x4 __attribute__((ext_vector_type(4)));
typedef unsigned u32x2 __attribute__((ext_vector_type(2)));

constexpr int DM = 1024, NB = 8, SEQ = 4096, CTXL = 256, DEPTH = 4;
constexpr int TL = NB * SEQ;
constexpr int TC = NB * CTXL;
constexpr int T = TL + TC;
constexpr int NPM = T / 256;
constexpr int DIN = 9472, NMAIN = 6400;
constexpr float LOG2E = 1.4426950408889634f;
constexpr float QS = 0.125f * LOG2E;

constexpr size_t MiB = 1u << 20;
constexpr size_t SZ_TOK = (size_t)T * 1024 * 2;
constexpr size_t WS_CTL = 0, WS_MODS = 32768, WS_ROPE = WS_MODS + 442368, WS_BS = WS_ROPE + 8192, WS_HC = WS_BS + 2228224;
constexpr size_t WS_WBR = WS_HC + 8388608, WS_WOUT = WS_WBR + 3145728, WS_WIN2 = WS_WOUT + 2097152;
constexpr size_t WS_ZRW = WS_WIN2 + (size_t)7680 * 2048, WS_NAQ = WS_ZRW + (size_t)T * 1792 * 2, WS_DFQ = WS_NAQ + (size_t)T * 1536 * 2;
constexpr size_t WS_G3 = WS_DFQ + (size_t)T * 1536 * 2, WS_HX = WS_G3 + (size_t)T * 1536 * 2;
constexpr size_t WS_WINRW = WS_HX + SZ_TOK;
constexpr size_t WS_END = WS_WINRW + (size_t)1792 * 2048;
constexpr size_t WS_YFB = WS_WINRW, WS_END2 = WS_YFB + SZ_TOK;
constexpr size_t WS_SG = WS_NAQ, WS_MPART = WS_ZRW, WS_YBUF = WS_ZRW + 32 * MiB, WS_M = WS_HX;
static_assert(WS_END2 == 620322816ull && WS_YBUF + SZ_TOK <= WS_NAQ, "workspace map");
constexpr int LDS_BYTES = 147456;
constexpr int NPHASE = 30;

struct Params { const float* in[25]; float* out; unsigned char* ws; int ph_lo, ph_hi, ovl, pad; };
enum { I_X = 0, I_C, I_CTX, I_CCTX, I_WMOD, I_BMOD, I_GPRE, I_GPOST, I_WIN, I_MU, I_KK, I_KA, I_RK, I_W0, I_WUP, I_A0, I_AUP, I_LNG, I_LNB, I_RPB, I_LAMQ, I_LAMK, I_SUBLN, I_WBR, I_WOUT };

__device__ __forceinline__ float bf2f(unsigned u) { return __uint_as_float(u << 16); }
__device__ __forceinline__ unsigned f2bf(float f) { unsigned u = __float_as_uint(f); return (u + 0x7fffu + ((u >> 16) & 1u)) >> 16; }
typedef __bf16 hbf16x2 __attribute__((ext_vector_type(2)));
__device__ __forceinline__ unsigned pk2(float lo, float hi) { f32x2 v = {lo, hi}; hbf16x2 b = __builtin_convertvector(v, hbf16x2); return __builtin_bit_cast(unsigned, b); }
__device__ __forceinline__ float dpp_xor1(float v) { return __int_as_float(__builtin_amdgcn_update_dpp(0, __float_as_int(v), 0xB1, 0xF, 0xF, true)); }
__device__ __forceinline__ float dpp_xor2(float v) { return __int_as_float(__builtin_amdgcn_update_dpp(0, __float_as_int(v), 0x4E, 0xF, 0xF, true)); }
__device__ __forceinline__ float dpp_hmir(float v) { return __int_as_float(__builtin_amdgcn_update_dpp(0, __float_as_int(v), 0x141, 0xF, 0xF, true)); }
__device__ __forceinline__ float sum8(float v) { v += dpp_xor1(v); v += dpp_xor2(v); v += dpp_hmir(v); return v; }
__device__ __forceinline__ float dpp_rmir(float v) { return __int_as_float(__builtin_amdgcn_update_dpp(0, __float_as_int(v), 0x140, 0xF, 0xF, true)); }
__device__ __forceinline__ float xor32_get(float x, int hi) { auto rr = __builtin_amdgcn_permlane32_swap(__float_as_uint(x), __float_as_uint(x), false, false); return __uint_as_float(hi ? rr[0] : rr[1]); }
__device__ __forceinline__ float xor32_sum(float x) { auto rr = __builtin_amdgcn_permlane32_swap(__float_as_uint(x), __float_as_uint(x), false, false); return __uint_as_float(rr[0]) + __uint_as_float(rr[1]); }
__device__ __forceinline__ float xor32_max(float x) { auto rr = __builtin_amdgcn_permlane32_swap(__float_as_uint(x), __float_as_uint(x), false, false); return fmaxf(__uint_as_float(rr[0]), __uint_as_float(rr[1])); }
__device__ __forceinline__ float xor16_sum(float x) { auto rr = __builtin_amdgcn_permlane16_swap(__float_as_uint(x), __float_as_uint(x), false, false); return __uint_as_float(rr[0]) + __uint_as_float(rr[1]); }
__device__ __forceinline__ float wave_sum(float v) { v = sum8(v); v += dpp_rmir(v); v = xor16_sum(v); return xor32_sum(v); }
__device__ __forceinline__ void unpack8(u32x4 w, float* f) {
    f[0] = bf2f(w.x & 0xffffu); f[1] = bf2f(w.x >> 16); f[2] = bf2f(w.y & 0xffffu); f[3] = bf2f(w.y >> 16);
    f[4] = bf2f(w.z & 0xffffu); f[5] = bf2f(w.z >> 16); f[6] = bf2f(w.w & 0xffffu); f[7] = bf2f(w.w >> 16);
}
__device__ __forceinline__ u32x4 pack8(const float* f) { u32x4 w; w.x = pk2(f[0], f[1]); w.y = pk2(f[2], f[3]); w.z = pk2(f[4], f[5]); w.w = pk2(f[6], f[7]); return w; }

struct Sched {
    int mode;
    pg8::StaticOrder so; int G, c, npm;
    const unsigned* ready; unsigned need;
    __device__ __forceinline__ bool next(int i, pg8::Unit& u) const {
        if (mode == 0) return so.next(i, u);
        if (mode == 1) {
            const int k = i / 3, pm = (c & 7) + 8 * (c >> 5) + 64 * k, pn = (c >> 3) & 3;
            if (pm >= npm) return false;
            const int n = i % 3; u.pm = n * NPM + pm; u.pn = n * 4 + pn; return true;
        }
        int pm, pn;
        const int x = c & 7, y = c >> 3;
        if (c >= 32 && i < 2) { const int y1 = y - 4, pe = x + 8 * (y1 >> 2) + 56 * i; pm = pe < 56 ? pe + 8 : pe + 16; pn = y1 & 3; }
        else if (c < 32 && i == 0) { pm = x; pn = y; }
        else if (c >= 32 && c < 96 && i == 2) { const int y2 = y - 4, pl = 8 + x + 8 * (y2 >> 2); pm = pl < 16 ? 56 + pl : 112 + pl; pn = y2 & 3; }
        else return false;
        if (pm >= npm) return false;
        u.pm = pm; u.pn = pn; return true;
    }
    __device__ __forceinline__ void a_ready(const pg8::Unit& u) const {
        if (mode != 2) return;
        if (threadIdx.x < 64) {
            unsigned polls = 0;
            while ((unsigned)__builtin_amdgcn_readfirstlane(__hip_atomic_load(ready + u.pm, __ATOMIC_RELAXED, __HIP_MEMORY_SCOPE_AGENT)) < need) { __builtin_amdgcn_s_sleep(2); if (++polls > (1u << 22)) break; }
            __builtin_amdgcn_fence(__ATOMIC_ACQUIRE, "agent");
            asm volatile("s_waitcnt vmcnt(0)" ::: "memory");
        }
        asm volatile("" ::: "memory"); __builtin_amdgcn_s_barrier(); asm volatile("" ::: "memory");
    }
    __device__ __forceinline__ void done(const pg8::Unit&) const {}
};

struct Epi {
    static constexpr bool PERM = true, AFTER_DRAIN = false;
    int mode, pn_off;
    bf16_t *zrw, *naq, *dfq, *g3, *sg, *mout, *ybuf; float *mpart; const f32x2* rope;
    __device__ __forceinline__ void operator()(const f32x4 (&acc)[2][2][4][2], const pg8::Unit& u, int wr_, int wc_, int fr_, int fq_) const {
        int tq = threadIdx.x; asm volatile("" : "+v"(tq));
        const int lane = tq & 63, wid = tq >> 6, wr = wid >> 2, wc = wid & 3, fr = lane & 15, fq = lane >> 4;
        if (mode <= 1) {
            const int pn = u.pn + pn_off; unsigned char* base; int ldc, colt, act = 0; float scl = 1.f; bool rp = false;
            if (mode == 1) { base = (unsigned char*)sg; ldc = 3072; colt = pn * 256; act = 2; }
            else if (pn < 7) { base = (unsigned char*)zrw; ldc = 1792; colt = pn * 256; }
            else if (pn < 9) { base = (unsigned char*)g3; ldc = 512; colt = (pn - 7) * 256; act = 1; }
            else if (pn < 15) { base = (unsigned char*)naq; ldc = 1536; colt = (pn - 9) * 256; if (pn < 11) scl = QS; }
            else if (pn < 17) { base = (unsigned char*)(g3 + (size_t)T * 512); ldc = 512; colt = (pn - 15) * 256; act = 1; }
            else if (pn < 23) { base = (unsigned char*)dfq; ldc = 1536; colt = (pn - 17) * 256; if (pn < 19) scl = QS; rp = (pn < 21) && (u.pm < 128); }
            else { base = (unsigned char*)(g3 + (size_t)2 * T * 512); ldc = 512; colt = (pn - 23) * 256; act = 1; }
            const int row0 = u.pm * 256 + wr * 64 + fr, col0 = colt + wc * 32 + 8 * fq;
#pragma unroll
            for (int ai = 0; ai < 2; ++ai)
#pragma unroll
                for (int m = 0; m < 4; ++m) {
                    int row = row0 + ai * 128 + m * 16; asm volatile("" : "+v"(row));
                    const unsigned off = ((unsigned)row * (unsigned)ldc + (unsigned)col0) * 2u;
                    float cs[8], sn[8];
                    if (rp) {
                        const int t = row & 4095; const int pos = (wc & 1) ? (t & 63) : (t >> 6);
                        const f32x4* rt = (const f32x4*)(rope + pos * 16 + 8 * (fq & 1));
#pragma unroll
                        for (int e = 0; e < 4; ++e) { const f32x4 q = rt[e]; cs[2 * e] = q.x; sn[2 * e] = q.y; cs[2 * e + 1] = q.z; sn[2 * e + 1] = q.w; }
                    }
#pragma unroll
                    for (int bj = 0; bj < 2; ++bj) {
                        float v[8];
#pragma unroll
                        for (int e = 0; e < 4; ++e) { v[e] = acc[ai][bj][m][0][e]; v[4 + e] = acc[ai][bj][m][1][e]; }
                        if (rp) {
#pragma unroll
                            for (int e = 0; e < 8; ++e) { const float xp = xor32_get(v[e], fq >> 1); v[e] = (fq < 2) ? (v[e] * cs[e] - xp * sn[e]) : (v[e] * cs[e] + xp * sn[e]); }
                        }
                        if (act == 1) {
#pragma unroll
                            for (int e = 0; e < 8; ++e) v[e] = v[e] * __builtin_amdgcn_rcpf(1.f + __expf(-v[e]));
                        } else if (act == 2) {
#pragma unroll
                            for (int e = 0; e < 8; ++e) v[e] = __builtin_amdgcn_rcpf(1.f + __expf(-v[e]));
                        }
#pragma unroll
                        for (int e = 0; e < 8; ++e) v[e] *= scl;
                        *(u32x4*)(base + off + bj * 256) = pack8(v);
                    }
                    asm volatile("" ::: "memory");
                }
        } else if (mode == 2) {
            const int n = u.pn >> 2, pn = u.pn & 3, pm = u.pm - n * NPM;
            bf16_t* part = (bf16_t*)mpart + (size_t)blockIdx.x * 65536;
            const unsigned char* sgb = (const unsigned char*)(sg + (size_t)pm * 256 * 3072 + n * 1024 + pn * 256);
            unsigned char* mb = (unsigned char*)(mout + (size_t)pm * 256 * 1024 + pn * 256);
            const int lr0 = wr * 64 + fr, lc0 = wc * 32 + 8 * fq;
#pragma unroll
            for (int ai = 0; ai < 2; ++ai)
                {
                    int lrb = lr0 + ai * 128; asm volatile("" : "+v"(lrb));
                    u32x4 gq[4][2], pq[4][2];
#pragma unroll
                    for (int mm = 0; mm < 4; ++mm)
#pragma unroll
                        for (int bj = 0; bj < 2; ++bj) {
                            const int lr = lrb + mm * 16, lc = lc0 + bj * 128;
                            gq[mm][bj] = *(const u32x4*)(sgb + ((unsigned)lr * 3072u + (unsigned)lc) * 2u);
                            if (n > 0) pq[mm][bj] = *(const u32x4*)(part + lr * 256 + lc);
                        }
                    asm volatile("" ::: "memory");
#pragma unroll
                    for (int mm = 0; mm < 4; ++mm)
#pragma unroll
                        for (int bj = 0; bj < 2; ++bj) {
                            const int m = mm, lr = lrb + mm * 16, lc = lc0 + bj * 128;
                            float g[8]; unpack8(gq[mm][bj], g);
                            float v[8];
#pragma unroll
                            for (int e = 0; e < 4; ++e) { v[e] = acc[ai][bj][m][0][e] * g[e]; v[4 + e] = acc[ai][bj][m][1][e] * g[4 + e]; }
                            if (n > 0) { float pv_[8]; unpack8(pq[mm][bj], pv_);
#pragma unroll
                                for (int e = 0; e < 8; ++e) v[e] += pv_[e]; }
                            if (n < 2) *(u32x4*)(part + lr * 256 + lc) = pack8(v);
                            else *(u32x4*)(mb + ((unsigned)lr * 1024u + (unsigned)lc) * 2u) = pack8(v);
                        }
                    asm volatile("" ::: "memory");
                }
        } else {
            const int row0 = u.pm * 256 + wr * 64 + fr, col0 = u.pn * 256 + wc * 32 + 8 * fq;
#pragma unroll
            for (int ai = 0; ai < 2; ++ai)
#pragma unroll
                for (int m = 0; m < 4; ++m) {
                    int row = row0 + ai * 128 + m * 16; asm volatile("" : "+v"(row));
                    bf16_t* rowp = ybuf + (size_t)row * 1024 + col0;
#pragma unroll
                    for (int bj = 0; bj < 2; ++bj) { const f32x4 a = acc[ai][bj][m][0], b = acc[ai][bj][m][1];
                        *(u32x4*)(rowp + bj * 128) = (u32x4){pk2(a[0], a[1]), pk2(a[2], a[3]), pk2(b[0], b[1]), pk2(b[2], b[3])}; }
                    asm volatile("" ::: "memory");
                }
        }
    }
};

__device__ __forceinline__ void transpose_item(const float* W, int K, int N, bf16_t* WT, LAS float* scr, int item, int lane) {
    const int nblk = N / 32, kb = item / nblk, nb = item % nblk, k0 = 64 * kb, n0 = 32 * nb;
#pragma unroll 8
    for (int i = 0; i < 32; ++i) { const int kk = 2 * i + (lane >> 5); scr[kk * 33 + (lane & 31)] = W[(size_t)(k0 + kk) * N + n0 + (lane & 31)]; }
    asm volatile("s_waitcnt lgkmcnt(0)" ::: "memory");
    const int c = lane & 7;
#pragma unroll
    for (int j = 0; j < 4; ++j) { const int n = (lane >> 3) + 8 * j; const LAS float* s = scr + (8 * c) * 33 + n;
        u32x4 o; o.x = pk2(s[0 * 33], s[1 * 33]); o.y = pk2(s[2 * 33], s[3 * 33]); o.z = pk2(s[4 * 33], s[5 * 33]); o.w = pk2(s[6 * 33], s[7 * 33]);
        *(u32x4*)(WT + (size_t)(n0 + n) * K + k0 + 8 * c) = o; }
    asm volatile("s_waitcnt lgkmcnt(0)" ::: "memory");
}
__device__ __forceinline__ void convert_weights(const Params& p, int l, unsigned char* lds) {
    const int tid_ = otid(); const int wave = tid_ >> 6, lane = tid_ & 63;
    LAS float* scr = (LAS float*)((LAS unsigned char*)lds + wave * 8704);
    const int gw = blockIdx.x * 8 + wave, NGW = gridDim.x * 8;
    constexpr int I_IN = 16 * (DIN / 32), I_BR = 8 * 32, I_OUT = 16 * 32, NITEMS = I_IN + 3 * I_BR + I_OUT;
    bf16_t* winrw = (bf16_t*)(p.ws + WS_WINRW); bf16_t* win2 = (bf16_t*)(p.ws + WS_WIN2) - (size_t)1792 * 1024; bf16_t* wbr = (bf16_t*)(p.ws + WS_WBR); bf16_t* wout = (bf16_t*)(p.ws + WS_WOUT);
    for (int it = gw; it < NITEMS; it += NGW) {
        int r = it;
        if (r < I_IN) { transpose_item(p.in[I_WIN] + (size_t)l * 1024 * DIN, 1024, DIN, ((r % (DIN / 32)) * 32 < 1792) ? winrw : win2, scr, r, lane); continue; } r -= I_IN;
        if (r < 3 * I_BR) { const int n = r / I_BR; transpose_item(p.in[I_WBR] + ((size_t)l * 3 + n) * 512 * 1024, 512, 1024, wbr + (size_t)n * 1024 * 512, scr, r % I_BR, lane); continue; } r -= 3 * I_BR;
        transpose_item(p.in[I_WOUT] + (size_t)l * 1024 * 1024, 1024, 1024, wout, scr, r, lane);
    }
}

__device__ __forceinline__ void phase_prologue(const Params& p, unsigned char* lds) {
    const int tid = otid(), wave = tid >> 6, lane = tid & 63;
    float* mods = (float*)(p.ws + WS_MODS);
    if (blockIdx.x < 192) {
        float* sc = (float*)lds;
        float* red = (float*)(lds + 36864);
        for (int i = tid; i < 9 * 1024; i += 512) { const float v = (i < 8192) ? p.in[I_C][i] : p.in[I_CCTX][i - 8192]; sc[i] = v / (1.f + __expf(-v)); }
        __syncthreads();
        const int l = blockIdx.x / 48, cb = blockIdx.x % 48, col = cb * 64 + lane;
        const float* W = p.in[I_WMOD] + (size_t)l * 1024 * 3072;
        float a[9];
#pragma unroll
        for (int v = 0; v < 9; ++v) a[v] = 0.f;
#pragma unroll 16
        for (int k = wave * 128; k < wave * 128 + 128; ++k) { const float w = W[(size_t)k * 3072 + col];
#pragma unroll
            for (int v = 0; v < 9; ++v) a[v] += sc[v * 1024 + k] * w; }
#pragma unroll
        for (int v = 0; v < 9; ++v) red[(wave * 9 + v) * 64 + lane] = a[v];
        __syncthreads();
        for (int i = tid; i < 9 * 64; i += 512) { const int v = i >> 6, cl = i & 63; float s = 0.f;
#pragma unroll
            for (int w = 0; w < 8; ++w) s += red[(w * 9 + v) * 64 + cl];
            mods[((size_t)l * 9 + v) * 3072 + cb * 64 + cl] = s + p.in[I_BMOD][l * 3072 + cb * 64 + cl]; }
        __syncthreads();
    } else if (blockIdx.x == 192) {
        f32x2* rope = (f32x2*)(p.ws + WS_ROPE);
        for (int i = tid; i < 1024; i += 512) { const int pos = i >> 4, fi = i & 15;
            const float inv = exp2f(-(float)fi * (13.287712379549449f / 16.f));
            const float x = (float)pos * inv; float s, c; sincosf(x, &s, &c); rope[i] = (f32x2){c, s}; }
    }
    convert_weights(p, 0, lds);
}

__device__ __forceinline__ void hx_from_row(const Params& p, int l, int v, const f32x4 (&x)[4], int lane, bf16_t* hxrow) {
    float ss = 0.f;
#pragma unroll
    for (int j = 0; j < 4; ++j) ss += (x[j].x * x[j].x + x[j].y * x[j].y) + (x[j].z * x[j].z + x[j].w * x[j].w);
    const float rx = rsqrtf(wave_sum(ss) * (1.f / 1024.f) + 1e-6f);
    const float* mods = (const float*)(p.ws + WS_MODS) + ((size_t)l * 9 + v) * 3072;
#pragma unroll
    for (int j = 0; j < 4; ++j) { const int c = 4 * lane + 256 * j;
        const f32x4 g = *(const f32x4*)(p.in[I_GPRE] + l * 1024 + c), sh = *(const f32x4*)(mods + c), scv = *(const f32x4*)(mods + 1024 + c);
        const f32x4 h = x[j] * rx * g * (scv + 1.f) + sh;
        u32x2 o; o.x = pk2(h.x, h.y); o.y = pk2(h.z, h.w); *(u32x2*)(hxrow + c) = o; }
}
__device__ __forceinline__ void phase_rowpass(const Params& p, int l) {
    const int tid_ = otid(); const int wave = tid_ >> 6, lane = tid_ & 63;
    const int gw = blockIdx.x * 8 + wave, NGW = gridDim.x * 8;
    const bf16_t* ybuf = (const bf16_t*)(p.ws + WS_YBUF); float* hc = (float*)(p.ws + WS_HC); bf16_t* hx = (bf16_t*)(p.ws + WS_HX);
    const int nrows = (l == DEPTH) ? TL : T;
    constexpr int RP = 4;
#pragma unroll 1
    for (int row0 = gw; row0 < nrows; row0 += RP * NGW) {
        f32x4 x[RP][4], y[RP][4];
#pragma unroll
        for (int q = 0; q < RP; ++q) {
            const int row = min(row0 + q * NGW, nrows - 1); const bool lat = row < TL;
            const float* src = lat ? ((l <= 1 ? p.in[I_X] : (const float*)p.out) + (size_t)row * 1024) : ((l <= 1 ? p.in[I_CTX] : (const float*)hc) + (size_t)(row - TL) * 1024);
#pragma unroll
            for (int j = 0; j < 4; ++j) x[q][j] = *(const f32x4*)(src + 4 * lane + 256 * j);
            if (l > 0) {
#pragma unroll
                for (int j = 0; j < 4; ++j) { const u32x2 w = *(const u32x2*)(ybuf + (size_t)row * 1024 + 4 * lane + 256 * j); y[q][j] = (f32x4){bf2f(w.x & 0xffffu), bf2f(w.x >> 16), bf2f(w.y & 0xffffu), bf2f(w.y >> 16)}; }
            }
        }
        asm volatile("" ::: "memory");
#pragma unroll
        for (int q = 0; q < RP; ++q) {
            const int row = row0 + q * NGW;
            if (row < nrows) {
                const bool lat = row < TL; const int v = lat ? (row >> 12) : 8;
                if (l > 0) {
                    float ss = 0.f;
#pragma unroll
                    for (int j = 0; j < 4; ++j) ss += (y[q][j].x * y[q][j].x + y[q][j].y * y[q][j].y) + (y[q][j].z * y[q][j].z + y[q][j].w * y[q][j].w);
                    const float ry = rsqrtf(wave_sum(ss) * (1.f / 1024.f) + 1e-6f);
                    const float* gate = (const float*)(p.ws + WS_MODS) + ((size_t)(l - 1) * 9 + v) * 3072 + 2048;
                    float* dst = lat ? (p.out + (size_t)row * 1024) : (hc + (size_t)(row - TL) * 1024);
#pragma unroll
                    for (int j = 0; j < 4; ++j) { const int c = 4 * lane + 256 * j;
                        const f32x4 gp = *(const f32x4*)(p.in[I_GPOST] + (l - 1) * 1024 + c), gt = *(const f32x4*)(gate + c);
                        x[q][j] = x[q][j] + gt * (y[q][j] * ry * gp); *(f32x4*)(dst + c) = x[q][j]; }
                }
                if (l < DEPTH) hx_from_row(p, l, v, x[q], lane, hx + (size_t)row * 1024);
            }
        }
    }
}

__device__ __forceinline__ void phase_readout(const Params& p, int l, bool dynamic) {
    const int tid_ = otid(); const int wave = tid_ >> 6, lane = tid_ & 63;
    const int gw = blockIdx.x * 8 + wave, NGW = gridDim.x * 8;
    bf16_t* hx = (bf16_t*)(p.ws + WS_HX); const bf16_t* yfb = (const bf16_t*)(p.ws + (p.ovl ? WS_YFB : WS_HX)); const bf16_t* zrw = (const bf16_t*)(p.ws + WS_ZRW); bf16_t* g3 = (bf16_t*)(p.ws + WS_G3);
    const float* bs = (const float*)(p.ws + WS_BS); const float* hc = (const float*)(p.ws + WS_HC);
    const int c0 = 8 * lane, head = lane >> 3;
    constexpr int RP = 2;
    auto body = [&](int row0, int qs) {
        u32x4 ryf[RP], ryb[RP], rz[RP], rzp[RP], rzn[RP], rg[RP]; float bsum[RP], fp[RP], fn[RP]; f32x4 x[RP][4];
#pragma unroll
        for (int q = 0; q < RP; ++q) {
            const int row = min(row0 + q * qs, T - 1); const bool lat = row < TL;
            const int tpos = lat ? (row & 4095) : ((row - TL) & 255), slen = lat ? SEQ : CTXL;
            fp[q] = tpos > 0 ? 1.f : 0.f; fn[q] = tpos < slen - 1 ? 1.f : 0.f;
            const size_t rp_ = tpos > 0 ? row - 1 : row, rn_ = tpos < slen - 1 ? row + 1 : row;
            ryf[q] = *(const u32x4*)(yfb + (size_t)row * 1024 + c0); ryb[q] = *(const u32x4*)(yfb + (size_t)row * 1024 + 512 + c0);
            rz[q] = *(const u32x4*)(zrw + (size_t)row * 1792 + 1024 + c0); rzp[q] = *(const u32x4*)(zrw + rp_ * 1792 + 1024 + c0); rzn[q] = *(const u32x4*)(zrw + rn_ * 1792 + 1024 + c0);
            rg[q] = *(const u32x4*)(g3 + (size_t)row * 512 + c0);
            bsum[q] = bs[(size_t)row * 8 + head] + bs[((size_t)T + row) * 8 + head];
            if (!p.ovl) {
                const float* src = lat ? ((l == 0 ? p.in[I_X] : (const float*)p.out) + (size_t)row * 1024) : ((l == 0 ? p.in[I_CTX] : hc) + (size_t)(row - TL) * 1024);
#pragma unroll
                for (int j = 0; j < 4; ++j) x[q][j] = *(const f32x4*)(src + 4 * lane + 256 * j);
            } else {
#pragma unroll
                for (int j = 0; j < 4; ++j) x[q][j] = (f32x4){0.f, 0.f, 0.f, 0.f};
            }
        }
        asm volatile("" ::: "memory");
#pragma unroll
        for (int q = 0; q < RP; ++q) {
            const int row = row0 + q * qs;
            if (row < T) {
                const bool lat = row < TL; const int v = lat ? (row >> 12) : 8;
                float yf[8], yb[8], z[8], zp[8], zn[8], g[8];
                unpack8(ryf[q], yf); unpack8(ryb[q], yb); unpack8(rz[q], z); unpack8(rzp[q], zp); unpack8(rzn[q], zn); unpack8(rg[q], g);
                float y[8], sacc = 0.f;
#pragma unroll
                for (int e = 0; e < 8; ++e) { y[e] = yf[e] + yb[e]; sacc += y[e]; }
                const float mu = sum8(sacc) * (1.f / 64.f); float qq = 0.f;
#pragma unroll
                for (int e = 0; e < 8; ++e) { y[e] -= mu; qq += y[e] * y[e]; }
                const float rs = rsqrtf(sum8(qq) * (1.f / 64.f) + 64e-5f);
                const f32x4 lg0 = *(const f32x4*)(p.in[I_LNG] + l * 512 + c0), lg1 = *(const f32x4*)(p.in[I_LNG] + l * 512 + c0 + 4);
                const f32x4 lb0 = *(const f32x4*)(p.in[I_LNB] + l * 512 + c0), lb1 = *(const f32x4*)(p.in[I_LNB] + l * 512 + c0 + 4);
                const float* mup = p.in[I_MU] + (size_t)(l * 2 + 0) * 1792 + 1024 + c0; const float* mun = p.in[I_MU] + (size_t)(l * 2 + 1) * 1792 + 1024 + c0;
                const f32x4 mp0 = *(const f32x4*)mup, mp1 = *(const f32x4*)(mup + 4), mn0 = *(const f32x4*)mun, mn1 = *(const f32x4*)(mun + 4);
                float o[8];
#pragma unroll
                for (int e = 0; e < 8; ++e) {
                    const float lg = e < 4 ? lg0[e & 3] : lg1[e & 3], lb = e < 4 ? lb0[e & 3] : lb1[e & 3], mp = e < 4 ? mp0[e & 3] : mp1[e & 3], mn = e < 4 ? mn0[e & 3] : mn1[e & 3];
                    const float vv = z[e] + mp * (fp[q] * zp[e] - z[e]) + mn * (fn[q] * zn[e] - z[e]);
                    o[e] = (y[e] * rs * lg + lb + bsum[q] * vv) * g[e];
                }
                *(u32x4*)(g3 + (size_t)row * 512 + c0) = pack8(o);
                if (!p.ovl) hx_from_row(p, l, v, x[q], lane, hx + (size_t)row * 1024);
            }
        }
    };
    if (!dynamic) {
#pragma unroll 1
        for (int row0 = gw; row0 < T; row0 += RP * NGW) body(row0, NGW);
    } else {
        unsigned* ctr = (unsigned*)(p.ws + WS_CTL) + 64 * (48 + l);
#pragma unroll 1
        for (;;) {
            int c = 0;
            if (lane == 0) c = (int)atomicAdd(ctr, 1u);
            c = __builtin_amdgcn_readfirstlane(c);
            if (c >= T / 16) break;
#pragma unroll 1
            for (int k = 0; k < 8; ++k) body(16 * c + 2 * k, 1);
        }
    }
}

constexpr int SC_BUF = 0, SC_BUFSZ = 49152, SC_YL = 98304, SC_YLSZ = 8192, SC_WT = 114688, SC_XS = 133120, SC_XSSZ = 2304, SC_CST = 142336;
struct ScanRaw { u32x4 q[5][3]; };
__device__ __forceinline__ void scan_chain(const Params& p, int l, int chain, unsigned char* lds) {
    const int tid = otid(), wave = __builtin_amdgcn_readfirstlane(tid >> 6), lane = tid & 63, hi = lane >> 5;
    const int b = chain >> 4, h = (chain >> 1) & 7, dir = chain & 1;
    const bf16_t* zrw = (const bf16_t*)(p.ws + WS_ZRW); bf16_t* yfb = (bf16_t*)(p.ws + (p.ovl ? WS_YFB : WS_HX)); float* bs = (float*)(p.ws + WS_BS);
    unsigned char* wt = lds + SC_WT;
    { const float* wu = p.in[I_WUP] + ((size_t)(l * 2 + dir) * 64) * 512 + h * 64; const float* au = p.in[I_AUP] + ((size_t)(l * 2 + dir) * 64) * 512 + h * 64;
      for (int idx = tid; idx < 8192; idx += 512) { const int m = idx >> 12, i = (idx >> 6) & 63, j = idx & 63;
          const float v = (m ? au : wu)[(size_t)i * 512 + j]; *(bf16_t*)(wt + (m * 64 + j) * 144 + i * 2) = (bf16_t)f2bf(v); } }
    float* cst = (float*)(lds + SC_CST);
    for (int idx = tid; idx < 15 * 64; idx += 512) { const int q = idx >> 6, j = idx & 63; float v;
        if (q == 0) v = p.in[I_W0][(l * 2 + dir) * 512 + h * 64 + j]; else if (q == 1) v = p.in[I_A0][(l * 2 + dir) * 512 + h * 64 + j];
        else if (q == 2) v = p.in[I_KK][l * 512 + h * 64 + j]; else if (q == 3) v = p.in[I_KA][l * 512 + h * 64 + j]; else if (q == 4) v = p.in[I_RK][l * 512 + h * 64 + j];
        else { const int g = (q - 5) % 5, nx = (q - 5) / 5; const int col = g < 3 ? g * 512 + h * 64 + j : (g == 3 ? 1536 : 1664) + dir * 64 + j; v = p.in[I_MU][(size_t)(l * 2 + nx) * 1792 + col]; }
        cst[idx] = v; }
    constexpr int NC = (CTXL + SEQ) / 32;
    const int pw = wave - 4, tl = lane >> 3, jg = lane & 7, ch0 = h * 64 + 8 * jg;
    const int colq[5] = {ch0, 512 + ch0, 1024 + ch0, 1536 + dir * 64 + 8 * jg, 1664 + dir * 64 + 8 * jg};
    auto chunk_pos = [&](int c, int& len, size_t& rbase, int& t0) {
        const bool cx = c < CTXL / 32; len = cx ? CTXL : SEQ; rbase = cx ? (size_t)TL + b * CTXL : (size_t)b * SEQ;
        const int ci = cx ? c : c - CTXL / 32; t0 = dir == 0 ? ci * 32 : len - 32 * (ci + 1);
    };
    auto load_raw = [&](int c, ScanRaw& R) {
        int len, t0; size_t rbase; chunk_pos(c, len, rbase, t0);
        int ln_ = lane; asm volatile("" : "+v"(ln_)); const int tl = ln_ >> 3, jg = ln_ & 7, ch0 = h * 64 + 8 * jg;
        const int colq[5] = {ch0, 512 + ch0, 1024 + ch0, 1536 + dir * 64 + 8 * jg, 1664 + dir * 64 + 8 * jg};
        const int t = t0 + 8 * pw + tl; const size_t row = rbase + t;
        const size_t rp = t > 0 ? row - 1 : row, rn = t < len - 1 ? row + 1 : row;
#pragma unroll
        for (int qn = 0; qn < 5; ++qn) { R.q[qn][0] = *(const u32x4*)(zrw + row * 1792 + colq[qn]); R.q[qn][1] = *(const u32x4*)(zrw + rp * 1792 + colq[qn]); R.q[qn][2] = *(const u32x4*)(zrw + rn * 1792 + colq[qn]); }
    };
    auto process = [&](int c, ScanRaw& R, int cnext) {
        int len, t0; size_t rbase; chunk_pos(c, len, rbase, t0);
        int ln_ = lane; asm volatile("" : "+v"(ln_)); const int tl = ln_ >> 3, jg = ln_ & 7, hi = ln_ >> 5, lane = ln_;
        const int tch = 8 * pw + tl, t = t0 + tch; const size_t row = rbase + t;
        const float fp = t > 0 ? 1.f : 0.f, fn = t < len - 1 ? 1.f : 0.f;
        float us[5][8];
#pragma unroll
        for (int qn = 0; qn < 5; ++qn) {
            float z[8], zp[8], zn[8]; unpack8(R.q[qn][0], z); unpack8(R.q[qn][1], zp); unpack8(R.q[qn][2], zn);
            const float* mup = cst + (5 + qn) * 64 + 8 * jg; const float* mun = cst + (10 + qn) * 64 + 8 * jg;
            const f32x4 mp0 = *(const f32x4*)mup, mp1 = *(const f32x4*)(mup + 4), mn0 = *(const f32x4*)mun, mn1 = *(const f32x4*)(mun + 4);
#pragma unroll
            for (int e = 0; e < 8; ++e) { const float mp = e < 4 ? mp0[e & 3] : mp1[e & 3], mn = e < 4 ? mn0[e & 3] : mn1[e & 3];
                us[qn][e] = z[e] + mp * (fp * zp[e] - z[e]) + mn * (fn * zn[e] - z[e]); }
        }
        asm volatile("" ::: "memory");
        if (cnext < NC) load_raw(cnext, R);
        unsigned char* xs = lds + SC_XS + pw * SC_XSSZ;
        { float tw[8];
#pragma unroll
          for (int e = 0; e < 8; ++e) { const float ex = __expf(2.f * us[3][e]); tw[e] = 1.f - 2.f * __builtin_amdgcn_rcpf(ex + 1.f); }
          *(u32x4*)(xs + (0 * 8 + tl) * 144 + jg * 16) = pack8(tw); *(u32x4*)(xs + (1 * 8 + tl) * 144 + jg * 16) = pack8(us[4]); }
        asm volatile("s_waitcnt lgkmcnt(0)" ::: "memory");
        float* arr = (float*)(lds + SC_BUF + (c & 1) * SC_BUFSZ);
#pragma unroll
        for (int m = 0; m < 2; ++m)
#pragma unroll
            for (int nb = 0; nb < 2; ++nb) {
                f32x16 acc = {};
#pragma unroll
                for (int ks = 0; ks < 4; ++ks) {
                    const bf16x8 A = *(const bf16x8*)(xs + (m * 8 + (lane & 7)) * 144 + (16 * ks + 8 * hi) * 2);
                    const bf16x8 B = *(const bf16x8*)(wt + (m * 64 + 32 * nb + (lane & 31)) * 144 + (16 * ks + 8 * hi) * 2);
                    acc = __builtin_amdgcn_mfma_f32_32x32x16_bf16(A, B, acc, 0, 0, 0);
                }
                float* dst = arr + (m == 0 ? 0 : 3) * 2048 + (8 * pw + 4 * hi) * 64 + 32 * nb + (lane & 31);
                dst[0] = acc[0]; dst[64] = acc[1]; dst[128] = acc[2]; dst[192] = acc[3];
            }
        asm volatile("s_waitcnt lgkmcnt(0)" ::: "memory");
        float* a0p = arr + tch * 64 + 8 * jg;
        float wl[8], al[8];
        { const f32x4 a0 = *(const f32x4*)(a0p), a1 = *(const f32x4*)(a0p + 4), b0 = *(const f32x4*)(a0p + 3 * 2048), b1 = *(const f32x4*)(a0p + 3 * 2048 + 4);
#pragma unroll
          for (int e = 0; e < 4; ++e) { wl[e] = a0[e]; wl[4 + e] = a1[e]; al[e] = b0[e]; al[4 + e] = b1[e]; } }
        float dec[8], kd[8], bv[8], kk[8], av[8]; float n2 = 0.f, bon = 0.f;
        const float* c_w0 = cst + 0 * 64 + 8 * jg; const float* c_a0 = cst + 1 * 64 + 8 * jg;
        const float* c_kk = cst + 2 * 64 + 8 * jg; const float* c_ka = cst + 3 * 64 + 8 * jg; const float* c_rk = cst + 4 * 64 + 8 * jg;
#pragma unroll
        for (int e = 0; e < 8; ++e) {
            const float xw = c_w0[e] + wl[e];
            const float sp = fmaxf(-xw, 0.f) + __logf(1.f + __expf(-fabsf(xw)));
            dec[e] = __expf(-__expf(-sp - 0.5f));
            const float a = __builtin_amdgcn_rcpf(1.f + __expf(-(c_a0[e] + al[e])));
            kk[e] = us[1][e] * c_kk[e]; n2 += kk[e] * kk[e];
            kd[e] = us[1][e] * (1.f + (a - 1.f) * c_ka[e]);
            bon += us[0][e] * kd[e] * c_rk[e];
            av[e] = a;
        }
        n2 = sum8(n2); bon = sum8(bon);
        const float rn = 1.f / fmaxf(sqrtf(n2), 1e-12f);
#pragma unroll
        for (int e = 0; e < 8; ++e) { kk[e] *= rn; bv[e] = kk[e] * av[e]; kk[e] = -kk[e]; }
        *(f32x4*)(a0p + 0 * 2048) = (f32x4){dec[0], dec[1], dec[2], dec[3]}; *(f32x4*)(a0p + 0 * 2048 + 4) = (f32x4){dec[4], dec[5], dec[6], dec[7]};
        *(f32x4*)(a0p + 1 * 2048) = (f32x4){kd[0], kd[1], kd[2], kd[3]};     *(f32x4*)(a0p + 1 * 2048 + 4) = (f32x4){kd[4], kd[5], kd[6], kd[7]};
        *(f32x4*)(a0p + 2 * 2048) = (f32x4){kk[0], kk[1], kk[2], kk[3]};     *(f32x4*)(a0p + 2 * 2048 + 4) = (f32x4){kk[4], kk[5], kk[6], kk[7]};
        *(f32x4*)(a0p + 3 * 2048) = (f32x4){bv[0], bv[1], bv[2], bv[3]};     *(f32x4*)(a0p + 3 * 2048 + 4) = (f32x4){bv[4], bv[5], bv[6], bv[7]};
        *(f32x4*)(a0p + 4 * 2048) = (f32x4){us[0][0], us[0][1], us[0][2], us[0][3]}; *(f32x4*)(a0p + 4 * 2048 + 4) = (f32x4){us[0][4], us[0][5], us[0][6], us[0][7]};
        *(f32x4*)(a0p + 5 * 2048) = (f32x4){us[2][0], us[2][1], us[2][2], us[2][3]}; *(f32x4*)(a0p + 5 * 2048 + 4) = (f32x4){us[2][4], us[2][5], us[2][6], us[2][7]};
        if (jg == 0) bs[((size_t)dir * T + row) * 8 + h] = bon;
    };
    auto flush = [&](int c) {
        int len, t0; size_t rbase; chunk_pos(c, len, rbase, t0);
        int ln_ = lane; asm volatile("" : "+v"(ln_)); const int tl = ln_ >> 3, jg = ln_ & 7, ch0 = h * 64 + 8 * jg;
        const int tch = 8 * pw + tl; const size_t row = rbase + t0 + tch;
        const float* yl = (const float*)(lds + SC_YL + (c & 1) * SC_YLSZ) + tch * 64 + 8 * jg;
        const f32x4 y0 = *(const f32x4*)yl, y1 = *(const f32x4*)(yl + 4);
        u32x4 o; o.x = pk2(y0[0], y0[1]); o.y = pk2(y0[2], y0[3]); o.z = pk2(y1[0], y1[1]); o.w = pk2(y1[2], y1[3]);
        *(u32x4*)(yfb + row * 1024 + dir * 512 + ch0) = o;
    };
    const int rp = lane >> 3, cgp = lane & 7, i0 = 16 * wave + rp, i1 = i0 + 8;
    f32x2 S0[4], S1[4];
#pragma unroll
    for (int e = 0; e < 4; ++e) { S0[e] = (f32x2){0.f, 0.f}; S1[e] = (f32x2){0.f, 0.f}; }
    ScanRaw R;
    __syncthreads();
    if (wave >= 4) { load_raw(0, R); process(0, R, 1); }
    __syncthreads();
#pragma unroll 1
    for (int c = 0; c < NC; ++c) {
        if (wave < 4) {
            const float* arr = (const float*)(lds + SC_BUF + (c & 1) * SC_BUFSZ);
            float* yl = (float*)(lds + SC_YL + (c & 1) * SC_YLSZ);
            struct StepIn { f32x4 w0, w1, k0, k1, a0, a1, b0, b1, r0, r1; float v0, v1; };
            auto ld = [&](int s, StepIn& I) {
                const int ts = dir == 0 ? s : 31 - s; const float* ap = arr + ts * 64 + 8 * cgp;
                I.w0 = *(const f32x4*)(ap); I.w1 = *(const f32x4*)(ap + 4); I.k0 = *(const f32x4*)(ap + 2048); I.k1 = *(const f32x4*)(ap + 2048 + 4);
                I.a0 = *(const f32x4*)(ap + 4096); I.a1 = *(const f32x4*)(ap + 4096 + 4); I.b0 = *(const f32x4*)(ap + 6144); I.b1 = *(const f32x4*)(ap + 6144 + 4);
                I.r0 = *(const f32x4*)(ap + 8192); I.r1 = *(const f32x4*)(ap + 8192 + 4);
                I.v0 = arr[5 * 2048 + ts * 64 + i0]; I.v1 = arr[5 * 2048 + ts * 64 + i1];
            };
            auto comp = [&](int s, const StepIn& I) {
                const int ts = dir == 0 ? s : 31 - s;
                const f32x2 w[4] = {{I.w0[0], I.w0[1]}, {I.w0[2], I.w0[3]}, {I.w1[0], I.w1[1]}, {I.w1[2], I.w1[3]}};
                const f32x2 k[4] = {{I.k0[0], I.k0[1]}, {I.k0[2], I.k0[3]}, {I.k1[0], I.k1[1]}, {I.k1[2], I.k1[3]}};
                const f32x2 a[4] = {{I.a0[0], I.a0[1]}, {I.a0[2], I.a0[3]}, {I.a1[0], I.a1[1]}, {I.a1[2], I.a1[3]}};
                const f32x2 bb[4] = {{I.b0[0], I.b0[1]}, {I.b0[2], I.b0[3]}, {I.b1[0], I.b1[1]}, {I.b1[2], I.b1[3]}};
                const f32x2 r[4] = {{I.r0[0], I.r0[1]}, {I.r0[2], I.r0[3]}, {I.r1[0], I.r1[1]}, {I.r1[2], I.r1[3]}};
                f32x2 d0 = S0[0] * a[0] + S0[1] * a[1], d0b = S0[2] * a[2] + S0[3] * a[3];
                f32x2 d1 = S1[0] * a[0] + S1[1] * a[1], d1b = S1[2] * a[2] + S1[3] * a[3];
                d0 += d0b; d1 += d1b;
                const float sa0 = sum8(d0.x + d0.y), sa1 = sum8(d1.x + d1.y);
#pragma unroll
                for (int e = 0; e < 4; ++e) { S0[e] = S0[e] * w[e] + bb[e] * sa0 + k[e] * I.v0; S1[e] = S1[e] * w[e] + bb[e] * sa1 + k[e] * I.v1; }
                f32x2 y0 = S0[0] * r[0] + S0[1] * r[1], y0b = S0[2] * r[2] + S0[3] * r[3];
                f32x2 y1 = S1[0] * r[0] + S1[1] * r[1], y1b = S1[2] * r[2] + S1[3] * r[3];
                y0 += y0b; y1 += y1b;
                const float ya = sum8(y0.x + y0.y), yb = sum8(y1.x + y1.y);
                if (cgp == 0) { yl[ts * 64 + i0] = ya; yl[ts * 64 + i1] = yb; }
            };
            __builtin_amdgcn_s_setprio(3);
            StepIn IA, IB;
            ld(0, IA);
#pragma unroll 1
            for (int s = 0; s < 32; s += 2) {
                ld(s + 1, IB);
                comp(s, IA);
                if (s + 2 < 32) ld(s + 2, IA);
                comp(s + 1, IB);
            }
            __builtin_amdgcn_s_setprio(0);
        } else {
            if (c > 0) flush(c - 1);
            if (c + 1 < NC) process(c + 1, R, c + 2);
        }
        __syncthreads();
    }
    if (wave >= 4) flush(NC - 1);
    __syncthreads();
}

__device__ __forceinline__ s16x4 tr_read(const unsigned char* pgen) {
    return __builtin_bit_cast(s16x4, __builtin_amdgcn_ds_read_tr16_b64_v4i16((LAS s16x4*)(uintptr_t)(unsigned)(uintptr_t)pgen));
}
__device__ __forceinline__ float max3f_(float a, float b, float c) { float r; asm("v_max3_f32 %0, %1, %2, %3" : "=v"(r) : "v"(a), "v"(b), "v"(c)); return r; }
template <int KW, int DV, bool NA>
__device__ __forceinline__ void attn_loop(unsigned char* lds, const bf16_t* Kg, const bf16_t* Vg, int pitch,
                                          int n1, size_t base1, int ntile, size_t base2,
                                          const bf16x8 (&qf)[4], int kcoff, int act_lo, int act_hi,
                                          int na_r, int na_c, int na_row0, const float* rpbs,
                                          f32x16 (&o)[DV / 32], float& l_out) {
    constexpr int KSTR = KW * 2 + 16, VSTR = DV * 2 + 64, KCH = KW / 8, VCH = DV / 8, NK = KW / 64, NV = DV / 64;
    constexpr int STAGE = 64 * KSTR + 64 * VSTR;
    const int tid = otid(), lane = tid & 63, q32 = lane & 31, hi = lane >> 5;
    const bool gB = (tid >> 8) != 0;
    u32x4 kA[NK], vA[NV], kB[NK], vB[NV];
    auto rowbase = [&](int i) -> size_t { return i < n1 ? base1 + (size_t)64 * i : base2 + (size_t)64 * (i - n1); };
    auto prefetch = [&](int i, u32x4 (&kreg)[NK], u32x4 (&vreg)[NV]) {
        const size_t rb = rowbase(i);
#pragma unroll
        for (int e = 0; e < NK; ++e) { const int c = tid + 512 * e; kreg[e] = *(const u32x4*)(Kg + (rb + c / KCH) * pitch + (c % KCH) * 8); }
#pragma unroll
        for (int e = 0; e < NV; ++e) { const int c = tid + 512 * e; vreg[e] = *(const u32x4*)(Vg + (rb + c / VCH) * pitch + (c % VCH) * 8); }
    };
    auto stash = [&](int st, const u32x4 (&kreg)[NK], const u32x4 (&vreg)[NV]) {
        unsigned char* Kt = lds + st * STAGE; unsigned char* Vt = Kt + 64 * KSTR;
#pragma unroll
        for (int e = 0; e < NK; ++e) { const int c = tid + 512 * e; *(u32x4*)(Kt + (c / KCH) * KSTR + (c % KCH) * 16) = kreg[e]; }
#pragma unroll
        for (int e = 0; e < NV; ++e) { const int c = tid + 512 * e; *(u32x4*)(Vt + (c / VCH) * VSTR + (c % VCH) * 16) = vreg[e]; }
    };
    float m_ref = 0.f, l_run = 0.f; bool first = true;
    u32x4 pw[4];
    f32x16 negm = {}; asm volatile("" : "+v"(negm));
#pragma unroll
    for (int d = 0; d < DV / 32; ++d) o[d] = (f32x16){};
    auto is_active = [&](int i) -> bool { return (i >= n1) || (i >= act_lo && i < act_hi); };
    auto tile = [&](int i, const unsigned char* Kt, const unsigned char* Vt) {
        constexpr int DT = DV / 32;
        f32x16 p0, p1;
#pragma unroll
        for (int d0 = 0; d0 < 4; ++d0) {
            const bf16x8 a0 = *(const bf16x8*)(Kt + q32 * KSTR + (kcoff + 16 * d0 + 8 * hi) * 2);
            const bf16x8 a1 = *(const bf16x8*)(Kt + (32 + q32) * KSTR + (kcoff + 16 * d0 + 8 * hi) * 2);
            if (d0 == 0) { p0 = __builtin_amdgcn_mfma_f32_32x32x16_bf16(a0, qf[0], negm, 0, 0, 0); p1 = __builtin_amdgcn_mfma_f32_32x32x16_bf16(a1, qf[0], negm, 0, 0, 0); }
            else { p0 = __builtin_amdgcn_mfma_f32_32x32x16_bf16(a0, qf[d0], p0, 0, 0, 0); p1 = __builtin_amdgcn_mfma_f32_32x32x16_bf16(a1, qf[d0], p1, 0, 0, 0); }
        }
        if (NA && i < n1) {
            const int kr = na_row0 + i, dr = kr - na_r + 7;
            const int cs = min(max(na_c - 8, 0), 48);
            const float* rb = rpbs + dr * 31 - na_c + 15;
#pragma unroll
            for (int r = 0; r < 16; ++r) {
                const int kc0 = (r & 3) + 8 * (r >> 2) + 4 * hi, kc1 = kc0 + 32;
                const bool ok0 = (kc0 >= cs) && (kc0 < cs + 16), ok1 = (kc1 >= cs) && (kc1 < cs + 16);
                p0[r] = ok0 ? p0[r] + rb[kc0] : -1e30f;
                p1[r] = ok1 ? p1[r] + rb[kc1] : -1e30f;
            }
        }
        asm volatile("s_nop 15\n\ts_nop 7" : "+v"(p0), "+v"(p1));
        float mxa = max3f_(p0[0], p0[1], p1[0]), mxb = max3f_(p0[2], p0[3], p1[1]);
        mxa = max3f_(mxa, p1[2], p1[3]);
#pragma unroll
        for (int r = 4; r < 16; r += 4) { mxa = max3f_(mxa, p0[r], p0[r + 1]); mxb = max3f_(mxb, p0[r + 2], p0[r + 3]); mxa = max3f_(mxa, p1[r], p1[r + 1]); mxb = max3f_(mxb, p1[r + 2], p1[r + 3]); }
        float mx = max3f_(mxa, mxb, mxb);
        mx = xor32_max(mx);
        if (first || __any(mx > 6.f)) {
            const float dl = first ? mx : fmaxf(mx, 0.f);
            const float f = first ? 0.f : __builtin_amdgcn_exp2f(-dl);
            m_ref += dl; l_run *= f;
#pragma unroll
            for (int r = 0; r < 16; ++r) negm[r] = -m_ref;
            asm volatile("" : "+v"(negm));
#pragma unroll
            for (int r = 0; r < 16; ++r) { p0[r] -= dl; p1[r] -= dl; }
#pragma unroll
            for (int d = 0; d < DT; ++d)
#pragma unroll
                for (int r = 0; r < 16; ++r) o[d][r] *= f;
            first = false;
        }
        const unsigned vb = (unsigned)(uintptr_t)(Vt + (4 * hi + ((lane & 15) >> 2)) * VSTR + (16 * ((lane >> 4) & 1) + 4 * (lane & 3)) * 2);
        s16x4 lo[DT], hh[DT];
#define TR_ISSUE(KS, d) do { \
            asm volatile("ds_read_b64_tr_b16 %0, %1 offset:%c2" : "=&v"(lo[d]) : "v"(vb), "i"((16 * (KS)) * VSTR + 64 * (d)) : "memory"); \
            asm volatile("ds_read_b64_tr_b16 %0, %1 offset:%c2" : "=&v"(hh[d]) : "v"(vb), "i"((16 * (KS) + 8) * VSTR + 64 * (d)) : "memory"); } while (0)
#define PV_VF(d) ((bf16x8){lo[d][0], lo[d][1], lo[d][2], lo[d][3], hh[d][0], hh[d][1], hh[d][2], hh[d][3]})
#define LGKM_WAIT(N) do { if constexpr ((N) == 6) asm volatile("s_waitcnt lgkmcnt(6)" ::: "memory"); else if constexpr ((N) == 4) asm volatile("s_waitcnt lgkmcnt(4)" ::: "memory"); \
            else if constexpr ((N) == 2) asm volatile("s_waitcnt lgkmcnt(2)" ::: "memory"); else asm volatile("s_waitcnt lgkmcnt(0)" ::: "memory"); __builtin_amdgcn_sched_barrier(0); } while (0)
#define SM_SLICE(P, LO, HI) _Pragma("unroll") for (int r = (LO); r < (HI); ++r) { P[r] = __builtin_amdgcn_exp2f(P[r]); ps += P[r]; }
#define PACK8(P, B) ((u32x4){pk2(P[(B)], P[(B) + 1]), pk2(P[(B) + 2], P[(B) + 3]), pk2(P[(B) + 4], P[(B) + 5]), pk2(P[(B) + 6], P[(B) + 7])})
#pragma unroll
        for (int d = 0; d < DT; ++d) TR_ISSUE(0, d);
        float ps = 0.f;
        SM_SLICE(p0, 0, 8); pw[0] = PACK8(p0, 0);
#pragma unroll
        for (int d = 0; d < DT; ++d) {
            LGKM_WAIT(2 * (DT - 1));
            o[d] = __builtin_amdgcn_mfma_f32_32x32x16_bf16(PV_VF(d), __builtin_bit_cast(bf16x8, pw[0]), o[d], 0, 0, 0);
            TR_ISSUE(1, d);
            SM_SLICE(p0, 8 + d * (8 / DT), 8 + (d + 1) * (8 / DT));
            __builtin_amdgcn_sched_barrier(0);
        }
        pw[1] = PACK8(p0, 8);
#pragma unroll
        for (int d = 0; d < DT; ++d) {
            LGKM_WAIT(2 * (DT - 1));
            o[d] = __builtin_amdgcn_mfma_f32_32x32x16_bf16(PV_VF(d), __builtin_bit_cast(bf16x8, pw[1]), o[d], 0, 0, 0);
            TR_ISSUE(2, d);
            SM_SLICE(p1, d * (8 / DT), (d + 1) * (8 / DT));
            __builtin_amdgcn_sched_barrier(0);
        }
        pw[2] = PACK8(p1, 0);
#pragma unroll
        for (int d = 0; d < DT; ++d) {
            LGKM_WAIT(2 * (DT - 1));
            o[d] = __builtin_amdgcn_mfma_f32_32x32x16_bf16(PV_VF(d), __builtin_bit_cast(bf16x8, pw[2]), o[d], 0, 0, 0);
            TR_ISSUE(3, d);
            SM_SLICE(p1, 8 + d * (8 / DT), 8 + (d + 1) * (8 / DT));
            __builtin_amdgcn_sched_barrier(0);
        }
        pw[3] = PACK8(p1, 8);
        l_run += ps;
        asm volatile("s_waitcnt lgkmcnt(0)" ::: "memory"); __builtin_amdgcn_sched_barrier(0);
#pragma unroll
        for (int d = 0; d < DT; ++d) o[d] = __builtin_amdgcn_mfma_f32_32x32x16_bf16(PV_VF(d), __builtin_bit_cast(bf16x8, pw[3]), o[d], 0, 0, 0);
#undef TR_ISSUE
#undef PV_VF
#undef LGKM_WAIT
#undef SM_SLICE
#undef PACK8
    };
    prefetch(0, kA, vA); stash(0, kA, vA);
    if (ntile > 1) prefetch(1, kB, vB);
    if (ntile > 2) prefetch(2, kA, vA);
    __syncthreads();
    int st_cur = 0, st_prev = 2, st_next = 1;
    auto step = [&](int i, u32x4 (&kreg)[NK], u32x4 (&vreg)[NV]) {
        if (i + 1 < ntile) { stash(st_next, kreg, vreg); if (i + 3 < ntile) prefetch(i + 3, kreg, vreg); }
        const unsigned char* Kt = lds + st_cur * STAGE;
        if (is_active(i)) tile(i, Kt, Kt + 64 * KSTR);
        __syncthreads();
        const int t_ = st_prev; st_prev = st_cur; st_cur = st_next; st_next = t_;
    };
#pragma unroll 1
    for (int i = 0; i < ntile; i += 2) { step(i, kB, vB); if (i + 1 < ntile) step(i + 1, kA, vA); }
    l_out = xor32_sum(l_run);
}

constexpr int AT_X1 = 0, AT_RPB = 114688, AT_SLOT = 117760;
__device__ __forceinline__ void diff_unit(const Params& p, int l, int b, int h, size_t qrow0, int tile_lo, unsigned char* lds) {
    const int tid = otid(), wave = tid >> 6, lane = tid & 63, q32 = lane & 31, hi = lane >> 5, qg = wave >> 1, m = wave & 1;
    const bf16_t* dfq = (const bf16_t*)(p.ws + WS_DFQ); bf16_t* gout = (bf16_t*)(p.ws + WS_G3) + (size_t)2 * T * 512;
    const size_t qrow = qrow0 + qg * 32 + q32;
    bf16x8 qf[4];
#pragma unroll
    for (int d0 = 0; d0 < 4; ++d0) qf[d0] = *(const bf16x8*)(dfq + qrow * 1536 + h * 128 + m * 64 + 16 * d0 + 8 * hi);
    f32x16 o[4]; float lsum;
    const int n1 = 64 - tile_lo;
    attn_loop<128, 128, false>(lds, dfq + 512 + h * 128, dfq + 1024 + h * 128, 1536, n1, (size_t)b * SEQ, n1 + 4, (size_t)TL + b * CTXL,
                               qf, m * 64, 0, n1, 0, 0, 0, nullptr, o, lsum);
    const float il = 1.f / lsum;
    float* x1 = (float*)(lds + AT_X1) + qg * 4096;
    if (m == 1) {
#pragma unroll
        for (int d = 0; d < 4; ++d)
#pragma unroll
            for (int r = 0; r < 16; ++r) x1[(32 * d + (r & 3) + 8 * (r >> 2) + 4 * hi) * 32 + q32] = o[d][r] * il;
    }
    __syncthreads();
    if (m == 0) {
        float lam;
        { const float a = p.in[I_LAMQ][(l * 2 + 0) * 64 + lane] * p.in[I_LAMK][(l * 2 + 0) * 64 + lane], c = p.in[I_LAMQ][(l * 2 + 1) * 64 + lane] * p.in[I_LAMK][(l * 2 + 1) * 64 + lane];
          lam = __expf(wave_sum(a)) - __expf(wave_sum(c)); }
        float lf = (float)l; asm volatile("" : "+v"(lf));
        const float li = 0.8f - 0.6f * __expf(-0.3f * lf); lam += li;
        float ss = 0.f;
#pragma unroll
        for (int d = 0; d < 4; ++d)
#pragma unroll
            for (int r = 0; r < 16; ++r) { const float v = o[d][r] * il - lam * x1[(32 * d + (r & 3) + 8 * (r >> 2) + 4 * hi) * 32 + q32]; o[d][r] = v; ss += v * v; }
        ss = xor32_sum(ss);
        const float rn = rsqrtf(ss * (1.f / 128.f) + 1e-5f) * (1.f - li);
#pragma unroll
        for (int d = 0; d < 4; ++d)
#pragma unroll
            for (int g = 0; g < 4; ++g) {
                const int dd = 32 * d + 8 * g + 4 * hi;
                bf16_t* gp = gout + qrow * 512 + h * 128 + dd;
                const u32x2 gw = *(const u32x2*)gp;
                const f32x4 sg = *(const f32x4*)(p.in[I_SUBLN] + l * 128 + dd);
                const float v0 = o[d][4 * g + 0] * rn * sg[0] * bf2f(gw.x & 0xffffu), v1 = o[d][4 * g + 1] * rn * sg[1] * bf2f(gw.x >> 16);
                const float v2 = o[d][4 * g + 2] * rn * sg[2] * bf2f(gw.y & 0xffffu), v3 = o[d][4 * g + 3] * rn * sg[3] * bf2f(gw.y >> 16);
                u32x2 ow; ow.x = pk2(v0, v1); ow.y = pk2(v2, v3); *(u32x2*)gp = ow;
            }
    }
    __syncthreads();
}
__device__ __forceinline__ void na_unit(const Params& p, int l, int b, int h, int rb4, bool ctxq, unsigned char* lds) {
    const int tid = otid(), wave = tid >> 6, lane = tid & 63, q32 = lane & 31, hi = lane >> 5;
    const bf16_t* naq = (const bf16_t*)(p.ws + WS_NAQ); bf16_t* gout = (bf16_t*)(p.ws + WS_G3) + (size_t)T * 512;
    float* rpbs = (float*)(lds + AT_RPB);
    size_t qrow; int n1, act_lo = 0, act_hi = 0, na_r = 0, na_c = 0, row_lo = 0;
    if (!ctxq) {
        const int R0 = 4 * rb4, r = R0 + (wave >> 1), c = 32 * (wave & 1) + q32;
        row_lo = min(max(R0 - 4, 0), 56); const int row_hi = min(max(R0 + 3 - 4, 0), 56) + 7;
        n1 = row_hi - row_lo + 1;
        const int rs = min(max(r - 4, 0), 56); act_lo = rs - row_lo; act_hi = act_lo + 8; na_r = r; na_c = c;
        qrow = (size_t)b * SEQ + r * 64 + c;
        for (int i = tid; i < 15 * 31; i += 512) rpbs[i] = p.in[I_RPB][((size_t)(l * 8 + h) * 15) * 31 + i] * LOG2E;
    } else { n1 = 0; qrow = (size_t)TL + b * CTXL + wave * 32 + q32; }
    bf16x8 qf[4];
#pragma unroll
    for (int d0 = 0; d0 < 4; ++d0) qf[d0] = *(const bf16x8*)(naq + qrow * 1536 + h * 64 + 16 * d0 + 8 * hi);
    f32x16 o[2]; float lsum;
    attn_loop<64, 64, true>(lds, naq + 512 + h * 64, naq + 1024 + h * 64, 1536, n1, (size_t)b * SEQ + (size_t)row_lo * 64, n1 + 4, (size_t)TL + b * CTXL,
                            qf, 0, act_lo, act_hi, na_r, na_c, row_lo, rpbs, o, lsum);
    const float il = 1.f / lsum;
#pragma unroll
    for (int d = 0; d < 2; ++d)
#pragma unroll
        for (int g = 0; g < 4; ++g) {
            const int dd = 32 * d + 8 * g + 4 * hi;
            bf16_t* gp = gout + qrow * 512 + h * 64 + dd;
            const u32x2 gw = *(const u32x2*)gp;
            const float v0 = o[d][4 * g + 0] * il * bf2f(gw.x & 0xffffu), v1 = o[d][4 * g + 1] * il * bf2f(gw.x >> 16);
            const float v2 = o[d][4 * g + 2] * il * bf2f(gw.y & 0xffffu), v3 = o[d][4 * g + 3] * il * bf2f(gw.y >> 16);
            u32x2 ow; ow.x = pk2(v0, v1); ow.y = pk2(v2, v3); *(u32x2*)gp = ow;
        }
    __syncthreads();
}

__device__ __forceinline__ void run_gemm(const Params& p, int kind, unsigned char* lds, int G, int c, int mrows = T, bool gated = false, unsigned need = 0u) {
    bf16_t* hx = (bf16_t*)(p.ws + WS_HX); bf16_t* win2 = (bf16_t*)(p.ws + WS_WIN2);
    Epi E; E.mode = kind >= 4 ? 0 : kind; E.pn_off = kind == 5 ? 7 : 0;
    E.zrw = (bf16_t*)(p.ws + WS_ZRW); E.naq = (bf16_t*)(p.ws + WS_NAQ); E.dfq = (bf16_t*)(p.ws + WS_DFQ); E.g3 = (bf16_t*)(p.ws + WS_G3);
    E.sg = (bf16_t*)(p.ws + WS_SG); E.mout = (bf16_t*)(p.ws + WS_M); E.mpart = (float*)(p.ws + WS_MPART); E.ybuf = (bf16_t*)(p.ws + WS_YBUF); E.rope = (const f32x2*)(p.ws + WS_ROPE);
    pg8::Gemm g; Sched S; S.mode = 0; S.G = G; S.c = c; S.npm = mrows / 256; S.ready = nullptr; S.need = 0u;
    if (kind == 4) { g = pg8::Gemm{hx, (const bf16_t*)(p.ws + WS_WINRW), T, 1792, 1024}; S.so.init(T, 1792, G, c); }
    else if (kind == 5) { g = pg8::Gemm{hx, win2, T, 4608, 1024}; S.so.init(T, 4608, G, c); }
    else if (kind == 1) { g = pg8::Gemm{hx, win2 + (size_t)4608 * 1024, mrows, 3072, 1024}; S.so.init(mrows, 3072, G, c); }
    else if (kind == 2) { g = pg8::Gemm{(const bf16_t*)(p.ws + WS_G3), (const bf16_t*)(p.ws + WS_WBR), 3 * T, 3072, 512}; S.mode = 1; S.so.init(T, 1024, G, c); }
    else { g = pg8::Gemm{(const bf16_t*)(p.ws + WS_M), (const bf16_t*)(p.ws + WS_WOUT), mrows, 1024, 1024}; S.so.init(mrows, 1024, G, c); if (gated) { S.mode = 2; S.ready = (const unsigned*)(p.ws + WS_CTL) + 3400; S.need = need; } }
    pg8::gemm_phase<Epi, Sched, true, true>((PG8_LAS unsigned char*)lds, g, S, E);
}

constexpr int NQ_UNITS = 272;
__device__ __forceinline__ void phase_branches(const Params& p, int l, unsigned char* lds) {
    unsigned* gctr = (unsigned*)(p.ws + WS_CTL) + 64 * (40 + l);
    if (blockIdx.x < 128) scan_chain(p, l, blockIdx.x, lds);
    else if (p.ovl) {
        run_gemm(p, 5, lds, (int)gridDim.x - 128, (int)blockIdx.x - 128);
        asm volatile("s_waitcnt vmcnt(0)" ::: "memory");
        __syncthreads();
        if (otid() == 0) { __builtin_amdgcn_fence(__ATOMIC_RELEASE, "agent"); asm volatile("s_waitcnt vmcnt(0)" ::: "memory"); __hip_atomic_fetch_add(gctr, 1u, __ATOMIC_RELAXED, __HIP_MEMORY_SCOPE_AGENT); }
    }
    if (p.ovl) {
        if (otid() == 0) {
            unsigned sp = 0; const unsigned want = gridDim.x - 128;
            while (__hip_atomic_load(gctr, __ATOMIC_RELAXED, __HIP_MEMORY_SCOPE_AGENT) < want) { __builtin_amdgcn_s_sleep(2); if (++sp > (1u << 22)) break; }
            __builtin_amdgcn_fence(__ATOMIC_ACQUIRE, "agent"); asm volatile("s_waitcnt vmcnt(0)" ::: "memory");
        }
        __syncthreads();
    }
    volatile int* slot = (volatile int*)(lds + AT_SLOT);
    for (int kq = 0; kq < 8; ++kq) {
        const int x = (blockIdx.x + kq) & 7;
        unsigned* ctr = (unsigned*)(p.ws + WS_CTL) + 64 * (8 * l + x + 1);
        for (;;) {
            __syncthreads();
            if (otid() == 0) *slot = (int)atomicAdd(ctr, 1u);
            __syncthreads();
            int j = *slot;
            if (j >= NQ_UNITS) break;
            if (j < 128) { const int bh = x + 8 * (j >> 5), b = bh >> 2, h = bh & 3, qb = j & 31; diff_unit(p, l, b, h, (size_t)b * SEQ + qb * 128, 0, lds); continue; }
            j -= 128;
            if (j < 128) { const int bh = x + 8 * (j >> 4), b = bh >> 3, h = bh & 7, rb4 = j & 15; na_unit(p, l, b, h, rb4, false, lds); continue; }
            j -= 128;
            if (j < 8) { const int bh = x + 8 * (j >> 1), b = bh >> 2, h = bh & 3, qb = j & 1; diff_unit(p, l, b, h, (size_t)TL + b * CTXL + qb * 128, 64, lds); continue; }
            j -= 8;
            { const int bh = x + 8 * j, b = bh >> 3, h = bh & 7; na_unit(p, l, b, h, 0, true, lds); }
        }
    }
}


#define XB_TMO      128
#define XB_XCNT(j)  (256  + 64 * (j))
#define XB_XSUB(j)  (1280 + 64 * (j))
#define XB_XGEN(j)  (2304 + 64 * (j))
#define XB_TOP      3328
#define XB_TOPGEN   3392
#define XCD_BAR_WORDS 3456
#define XB_SPIN_CAP (1u << 18)

__device__ __forceinline__ unsigned xb_ld(unsigned* p)              { return __hip_atomic_load(p, __ATOMIC_RELAXED, __HIP_MEMORY_SCOPE_AGENT); }
__device__ __forceinline__ unsigned xb_add(unsigned* p, unsigned v) { return __hip_atomic_fetch_add(p, v, __ATOMIC_RELAXED, __HIP_MEMORY_SCOPE_AGENT); }
__device__ __forceinline__ unsigned xb_xcc_id() { return (unsigned)__builtin_amdgcn_s_getreg((3 << 11) | 20) & 0xFu; }
#define XB_SPIN(cond, bar) do { unsigned _sp = 0; while (cond) { __builtin_amdgcn_s_sleep(1); \
    if ((++_sp & 255u) == 0u) { if (xb_ld(&(bar)[XB_TMO])) break; if (_sp > XB_SPIN_CAP) { atomicAdd(&(bar)[XB_TMO], 1u); break; } } } } while (0)

struct XcdBarrier {
    unsigned* bar; unsigned x;
    volatile LAS unsigned* st;
};

__device__ __forceinline__ XcdBarrier xcd_barrier_post(unsigned* bar, volatile LAS unsigned* st) {
    XcdBarrier b; b.bar = bar; b.x = xb_xcc_id(); b.st = st;
    if (threadIdx.x == 0) (void)xb_add(&bar[XB_XCNT(b.x)], 1u);
    return b;
}
__device__ __forceinline__ void xcd_barrier_complete(unsigned* bar, unsigned x, unsigned& nloc, unsigned& nx) {
    const unsigned G = gridDim.x * gridDim.y * gridDim.z;
    unsigned sum, cnt, mine, sp = 0u;
    for (;;) {
        sum = 0u; cnt = 0u; mine = 0u;
#pragma unroll
        for (unsigned j = 0; j < 16; ++j) { const unsigned c = xb_ld(&bar[XB_XCNT(j)]); sum += c; cnt += (c > 0u) ? 1u : 0u; mine = (j == x) ? c : mine; }
        if (sum == G) break;
        __builtin_amdgcn_s_sleep(1);
        if ((++sp & 255u) == 0u) { if (xb_ld(&bar[XB_TMO])) break; if (sp > XB_SPIN_CAP) { atomicAdd(&bar[XB_TMO], 1u); break; } }
    }
    nloc = mine > 0u ? mine : 1u; nx = cnt > 0u ? cnt : 1u;
}

__device__ __forceinline__ void xcd_barrier(const XcdBarrier& b) {
    asm volatile("s_waitcnt vmcnt(0)" ::: "memory");
    __syncthreads();
    if (threadIdx.x == 0) {
        unsigned* bar = b.bar;
        __builtin_amdgcn_s_waitcnt(0);
        unsigned nloc = b.st[0], nx = b.st[1];
        if (nloc == 0u) { xcd_barrier_complete(bar, b.x, nloc, nx); b.st[0] = nloc; b.st[1] = nx; }
        const unsigned old = xb_add(&bar[XB_XSUB(b.x)], 1u);
        const unsigned gen = old / nloc;
        if (old + 1u == (gen + 1u) * nloc) {
            __builtin_amdgcn_fence(__ATOMIC_RELEASE, "agent");
            asm volatile("s_waitcnt vmcnt(0)" ::: "memory");
            const unsigned og = xb_add(&bar[XB_TOP], 1u);
            const unsigned tg = og / nx;
            if (og + 1u == (tg + 1u) * nx) xb_add(&bar[XB_TOPGEN], 1u);
            else XB_SPIN(xb_ld(&bar[XB_TOPGEN]) == tg, bar);
            __builtin_amdgcn_fence(__ATOMIC_ACQUIRE, "agent");
            xb_add(&bar[XB_XGEN(b.x)], 1u);
            asm volatile("s_waitcnt vmcnt(0)" ::: "memory");
        } else {
            XB_SPIN(xb_ld(&bar[XB_XGEN(b.x)]) == gen, bar);
            __builtin_amdgcn_fence(__ATOMIC_ACQUIRE, "agent");
            asm volatile("s_waitcnt vmcnt(0)" ::: "memory");
        }
    }
    __syncthreads();
}


__global__ void __launch_bounds__(512, 2) mega_fwd(Params p) {
    extern __shared__ __attribute__((aligned(16))) unsigned char lds[];
    cg::grid_group grid = cg::this_grid();
    volatile LAS unsigned* bst = (volatile LAS unsigned*)((LAS unsigned char*)lds + LDS_BYTES - 64);
    if (threadIdx.x < 2) bst[threadIdx.x] = 0u;
    __syncthreads();
    XcdBarrier bar = xcd_barrier_post((unsigned*)(p.ws + WS_CTL) + 4096, bst);
    for (int ph = p.ph_lo; ph < p.ph_hi; ++ph) {
        if (p.ovl && ph > 0 && ph < NPHASE - 1 && ((ph - 1) % 7 == 4 || (ph - 1) % 7 == 6)) continue;
        if (ph == p.ph_lo + 1) grid.sync();
        else if (ph > p.ph_lo) xcd_barrier(bar);
        if (ph == 0) {
#ifndef NO_PRO
 phase_prologue(p, lds);
#endif
 continue; }
        if (ph == NPHASE - 1) { phase_rowpass(p, DEPTH); continue; }
        const int l = (ph - 1) / 7, s = (ph - 1) % 7;
        if (s == 0) {
#ifndef NO_ROW
 if (l > 0) convert_weights(p, l, lds); phase_rowpass(p, l);
#endif
 }
        else if (s == 1) {
#ifndef NO_GEMM
 run_gemm(p, 4, lds, gridDim.x, blockIdx.x); if (!p.ovl) { __syncthreads(); run_gemm(p, 5, lds, gridDim.x, blockIdx.x); }
#endif
 }
        else if (s == 2) {
#ifndef NO_BR
 phase_branches(p, l, lds);
#endif
 }
        else if (s == 3) {
#ifndef NO_RO
 if (p.ovl) { run_gemm(p, 1, lds, gridDim.x, blockIdx.x, l == DEPTH - 1 ? TL : T); __syncthreads(); phase_readout(p, l, true); } else phase_readout(p, l, false);
#endif
 }
        else {
#ifndef NO_GEMM
 const int mrows_ = l == DEPTH - 1 ? TL : T;
 run_gemm(p, s - 3, lds, gridDim.x, blockIdx.x, mrows_);
 if (p.ovl && s == 5) {
     asm volatile("s_waitcnt vmcnt(0)" ::: "memory");
     __syncthreads();
     if (otid() == 0) {
         __builtin_amdgcn_fence(__ATOMIC_RELEASE, "agent"); asm volatile("s_waitcnt vmcnt(0)" ::: "memory");
         unsigned* pc = (unsigned*)(p.ws + WS_CTL) + 3400;
         for (int k = 0; k < 3; ++k) { const int pm = ((int)blockIdx.x & 7) + 8 * ((int)blockIdx.x >> 5) + 64 * k; if (pm < mrows_ / 256) __hip_atomic_fetch_add(pc + pm, 1u, __ATOMIC_RELAXED, __HIP_MEMORY_SCOPE_AGENT); }
     }
     __syncthreads();
     run_gemm(p, 3, lds, gridDim.x, blockIdx.x, mrows_, true, 4u * (unsigned)(l + 1));
 }
#endif
 }
        __syncthreads();
    }
}

#ifndef N_LAUNCH_MODE
#define N_LAUNCH_MODE 1
#endif
extern "C" void kernel_launch(void* const* d_in, const int* in_sizes, int n_in, void* d_out, int out_size, void* d_ws, size_t ws_size, hipStream_t stream) {
    static int grid = 0;
    if (grid == 0) {
        if (n_in != 25 || out_size != TL * DM || ws_size < WS_END) { fprintf(stderr, "kernel_launch: unexpected sizes n_in %d out %d ws %zu\n", n_in, out_size, ws_size); grid = -1; return; }
        int dev = 0, cus = 0, per_cu = 0;
        hipGetDevice(&dev); hipDeviceGetAttribute(&cus, hipDeviceAttributeMultiprocessorCount, dev);
        hipFuncSetAttribute((const void*)mega_fwd, hipFuncAttributeMaxDynamicSharedMemorySize, LDS_BYTES);
        hipOccupancyMaxActiveBlocksPerMultiprocessor(&per_cu, (const void*)mega_fwd, 512, LDS_BYTES);
        (void)hipGetLastError();
        if (per_cu < 1) per_cu = 1;
        grid = cus;
        if (grid > cus * per_cu) grid = cus * per_cu;
        if (grid != 256) { fprintf(stderr, "kernel_launch: built for a 256-CU device (grid %d)\n", grid); grid = -1; return; }
    }
    if (grid < 0) return;
    hipMemsetAsync((char*)d_ws + WS_CTL, 0, 32768, stream);
    Params a{};
    for (int i = 0; i < 25; ++i) a.in[i] = (const float*)d_in[i];
    a.out = (float*)d_out; a.ws = (unsigned char*)d_ws; a.ovl = (ws_size >= WS_END2 && grid == 256) ? 1 : 0;
#if N_LAUNCH_MODE == 1
    a.ph_lo = 0; a.ph_hi = NPHASE;
    void* args[] = {&a};
    hipError_t e = hipLaunchCooperativeKernel((const void*)mega_fwd, dim3(grid), dim3(512), args, LDS_BYTES, stream);
    if (e != hipSuccess) fprintf(stderr, "cooperative launch failed: %s (grid %d)\n", hipGetErrorString(e), grid);
#else
    for (int ph = 0; ph < NPHASE; ++ph) { a.ph_lo = ph; a.ph_hi = ph + 1; hipLaunchKernelGGL(mega_fwd, dim3(grid), dim3(512), LDS_BYTES, stream, a); }
#endif
}
```

```cpp
#include <hip/hip_runtime.h>
#include <hip/hip_cooperative_groups.h>
#include <cstdio>
#include <cstdint>
namespace cg = cooperative_groups;
__device__ __forceinline__ int otid() { int t = threadIdx.x; asm volatile("" : "+v"(t)); return t; }
namespace pg8 {
#define PG8_LAS __attribute__((address_space(3)))
typedef unsigned short bf16_t;
typedef short bf16x8 __attribute__((ext_vector_type(8)));
typedef float f32x4 __attribute__((ext_vector_type(4)));
typedef unsigned u32x4 __attribute__((ext_vector_type(4)));
constexpr int BM = 256, BK = 64, HALF = 128, HTB = HALF * BK * 2  , STAGE_BYTES = 8 * HTB, NXCD = 8, WGM = 8;

__host__ __device__ __forceinline__ int lds_byte(int r, int c) { const int st = (r >> 4) * 2 + (c >> 5), rr = r & 15, cc = c & 31, ob = rr * 64 + cc * 2; return st * 1024 + (ob ^ (((ob >> 9) & 1) << 5)); }
__host__ __device__ __forceinline__ void stage_rc(int b, int& R, int& C) { const int st = b / 1024, sb = b % 1024, swz = sb ^ (((sb >> 9) & 1) << 5); R = (st >> 1) * 16 + swz / 64; C = (st & 1) * 32 + (swz % 64) / 2; }
__host__ __device__ __forceinline__ int perm32(int rho) { const int n = rho >> 4, i = rho & 15; return 8 * (i >> 2) + 4 * n + (i & 3); }

struct Unit { int pm, pn; };
struct Gemm { const bf16_t* A; const bf16_t* Bt; int M, N, K; };

struct StaticOrder {
    int nM, nN, nwg, G, c;
    __host__ __device__ void init(int M, int N, int G_, int c_) { nM = M / BM; nN = N / BM; nwg = nM * nN; G = G_; c = c_; }
    __host__ __device__ bool next(int i, Unit& u) const {
        const long L = (long)i * G + c; if (L >= nwg) return false;
        int wgid = (int)L; { const int q = nwg / NXCD, r = nwg % NXCD, xcd = wgid % NXCD, off = wgid / NXCD; wgid = (xcd < r ? xcd * (q + 1) : r * (q + 1) + (xcd - r) * q) + off; }
        const int nig = WGM * nN, gid = wgid / nig, fm = gid * WGM, gsz = (nM - fm) < WGM ? (nM - fm) : WGM;
        u.pm = fm + ((wgid % nig) % gsz); u.pn = (wgid % nig) / gsz; return true;
    }
    __device__ __forceinline__ void a_ready(const Unit&) const {}
    __device__ __forceinline__ void done(const Unit&) const {}
};

template <class Epi, class Sched, bool ALIGN_EPI = false, bool SP2 = false>
__device__ __forceinline__ void gemm_phase(PG8_LAS unsigned char* lds, const Gemm g, const Sched& S, const Epi& E) {
    const int tid = otid(), wid = __builtin_amdgcn_readfirstlane(tid >> 6), lane = tid & 63, wr = wid >> 2, wc = wid & 3, fr = lane & 15, fq = lane >> 4;
    const int K = g.K, nt = K / BK;
    unsigned voffA[2], voffB[2];
#pragma unroll
    for (int i = 0; i < 2; ++i) { int R, C; stage_rc(tid * 16 + i * 8192, R, C); const int Rb = Epi::PERM ? ((R & ~31) + perm32(R & 31)) : R;
        voffA[i] = (unsigned)(R * K + C) * 2u; voffB[i] = (unsigned)(Rb * K + C) * 2u; }
    const size_t kstep = (size_t)(BK * 2);
    const size_t hstep = (size_t)HALF * K * 2;
    const size_t tstep = 2 * hstep;
    const unsigned ldsw = (unsigned)wid * 1024u;
    const int aoff = lds_byte(wr * 64 + fr, fq * 8), boff = lds_byte(wc * 32 + fr, fq * 8);
#define PG8_SA(b, h) (((b) * 2 + (h)) * HTB)
#define PG8_SB(b, h) ((4 + (b) * 2 + (h)) * HTB)
#define PG8_STAGE(bufoff, gbase, voff) do { _Pragma("unroll") for (int _i = 0; _i < 2; ++_i) \
        __builtin_amdgcn_global_load_lds((const unsigned*)((const char*)(gbase) + (voff)[_i]), (PG8_LAS unsigned*)(lds + (bufoff) + ldsw + _i * 8192), 16, 0, 0); } while (0)
#define PG8_LDA(dst, b, h) do { _Pragma("unroll") for (int m = 0; m < 4; ++m) _Pragma("unroll") for (int k = 0; k < 2; ++k) dst[m][k] = *(const PG8_LAS bf16x8*)(lds + PG8_SA(b, h) + aoff + m * 2048 + k * 1024); } while (0)
#define PG8_LDB(dst, b, h) do { _Pragma("unroll") for (int n = 0; n < 2; ++n) _Pragma("unroll") for (int k = 0; k < 2; ++k) dst[n][k] = *(const PG8_LAS bf16x8*)(lds + PG8_SB(b, h) + boff + n * 2048 + k * 1024); } while (0)
#define PG8_MMA(ai, bj, At, Bt) do { __builtin_amdgcn_s_setprio(1); _Pragma("unroll") for (int m = 0; m < 4; ++m) _Pragma("unroll") for (int n = 0; n < 2; ++n) _Pragma("unroll") for (int k = 0; k < 2; ++k) \
        acc[ai][bj][m][n] = __builtin_amdgcn_mfma_f32_16x16x32_bf16(Bt[n][k], At[m][k], acc[ai][bj][m][n], 0, 0, 0); __builtin_amdgcn_s_setprio(0); } while (0)
#define PG8_WAIT_V(n) asm volatile("s_waitcnt vmcnt(" #n ")" ::: "memory")
#define PG8_WAIT_L(n) asm volatile("s_waitcnt lgkmcnt(" #n ")" ::: "memory")
#define PG8_BAR __builtin_amdgcn_s_barrier()
#define PG8_SCHED __builtin_amdgcn_sched_barrier(0)
    Unit cur, nxt; int ui = 0;
    if (!S.next(0, cur)) return;
    f32x4 acc[2][2][4][2];
#pragma unroll
    for (int a = 0; a < 2; ++a)
#pragma unroll
        for (int b = 0; b < 2; ++b)
#pragma unroll
            for (int m = 0; m < 4; ++m)
#pragma unroll
                for (int n = 0; n < 2; ++n) acc[a][b][m][n] = (f32x4){0.f, 0.f, 0.f, 0.f};
    bf16x8 At[4][2], B0[2][2], B1[2][2];
    const char* cA = (const char*)g.A + (size_t)cur.pm * tstep; const char* cB = (const char*)g.Bt + (size_t)cur.pn * tstep;
    S.a_ready(cur);
    if constexpr (SP2) {
        PG8_STAGE(PG8_SB(0, 0), cB, voffB); PG8_STAGE(PG8_SB(0, 1), cB + hstep, voffB); PG8_STAGE(PG8_SA(0, 0), cA, voffA); PG8_STAGE(PG8_SA(0, 1), cA + hstep, voffA);
        if (wr == 1) PG8_BAR;
        PG8_WAIT_V(2); PG8_BAR;
        PG8_STAGE(PG8_SB(1, 0), cB + kstep, voffB); PG8_STAGE(PG8_SA(1, 0), cA + kstep, voffA); PG8_STAGE(PG8_SB(1, 1), cB + hstep + kstep, voffB);
        PG8_WAIT_V(6); PG8_BAR;
    } else {
        PG8_STAGE(PG8_SB(0, 0), cB, voffB); PG8_STAGE(PG8_SA(0, 0), cA, voffA); PG8_STAGE(PG8_SB(0, 1), cB + hstep, voffB); PG8_STAGE(PG8_SA(0, 1), cA + hstep, voffA);
        if (wr == 1) PG8_BAR;
        PG8_WAIT_V(4); PG8_BAR;
        PG8_STAGE(PG8_SB(1, 0), cB + kstep, voffB); PG8_STAGE(PG8_SA(1, 0), cA + kstep, voffA); PG8_STAGE(PG8_SB(1, 1), cB + hstep + kstep, voffB);
        PG8_WAIT_V(6); PG8_BAR;
    }
    for (;;) {
        const bool has_next = S.next(ui + 1, nxt);
        const char* nA = has_next ? (const char*)g.A + (size_t)nxt.pm * tstep : cA; const char* nB = has_next ? (const char*)g.Bt + (size_t)nxt.pn * tstep : cB;
        for (int t = 0; t < nt; t += 2) {
            const bool last = (t == nt - 2);
            const char* a1 = cA + (size_t)(t + 1) * kstep;
            const char* a2 = last ? nA : cA + (size_t)(t + 2) * kstep; const char* b2 = last ? nB : cB + (size_t)(t + 2) * kstep;
            const char* a3 = a2 + kstep; const char* b3 = b2 + kstep;
            if (last && has_next) S.a_ready(nxt);
            if constexpr (SP2) {
            PG8_LDB(B0, 0, 0); PG8_LDB(B1, 0, 1); PG8_SCHED; PG8_LDA(At, 0, 0); PG8_STAGE(PG8_SA(1, 1), a1 + hstep, voffA);
            PG8_WAIT_V(8); PG8_WAIT_L(0); PG8_BAR; PG8_MMA(0, 0, At, B0); PG8_MMA(0, 1, At, B1); PG8_BAR; PG8_SCHED;
            PG8_LDA(At, 0, 1); PG8_STAGE(PG8_SB(0, 0), b2, voffB); PG8_STAGE(PG8_SB(0, 1), b2 + hstep, voffB); PG8_STAGE(PG8_SA(0, 0), a2, voffA);
            PG8_WAIT_V(8); PG8_WAIT_L(0); PG8_BAR; PG8_MMA(1, 0, At, B0); PG8_MMA(1, 1, At, B1); PG8_BAR; PG8_SCHED;
            PG8_LDB(B0, 1, 0); PG8_LDB(B1, 1, 1); PG8_SCHED; PG8_LDA(At, 1, 0); PG8_STAGE(PG8_SA(0, 1), a2 + hstep, voffA);
            PG8_WAIT_V(8); PG8_WAIT_L(0); PG8_BAR; PG8_MMA(0, 0, At, B0); PG8_MMA(0, 1, At, B1); PG8_BAR; PG8_SCHED;
            PG8_LDA(At, 1, 1); PG8_STAGE(PG8_SB(1, 0), b3, voffB); PG8_STAGE(PG8_SB(1, 1), b3 + hstep, voffB); PG8_STAGE(PG8_SA(1, 0), a3, voffA);
            PG8_WAIT_V(8); PG8_WAIT_L(0); PG8_BAR; PG8_MMA(1, 0, At, B0); PG8_MMA(1, 1, At, B1); PG8_BAR; PG8_SCHED;
            } else {
            PG8_LDB(B0, 0, 0); PG8_SCHED; PG8_LDA(At, 0, 0); PG8_STAGE(PG8_SA(1, 1), a1 + hstep, voffA);
            PG8_WAIT_L(8); PG8_BAR; PG8_WAIT_L(0); PG8_MMA(0, 0, At, B0); PG8_BAR; PG8_SCHED;
            PG8_LDB(B1, 0, 1); PG8_STAGE(PG8_SB(0, 0), b2, voffB);
            PG8_BAR; PG8_WAIT_L(0); PG8_MMA(0, 1, At, B1); PG8_BAR;
            PG8_LDA(At, 0, 1); PG8_STAGE(PG8_SA(0, 0), a2, voffA);
            PG8_BAR; PG8_WAIT_L(0); PG8_MMA(1, 0, At, B0); PG8_BAR; PG8_SCHED;
            PG8_STAGE(PG8_SB(0, 1), b2 + hstep, voffB);
            PG8_WAIT_V(6); PG8_BAR; PG8_MMA(1, 1, At, B1); PG8_BAR;
            PG8_LDB(B0, 1, 0); PG8_SCHED; PG8_LDA(At, 1, 0); PG8_STAGE(PG8_SA(0, 1), a2 + hstep, voffA);
            PG8_WAIT_L(8); PG8_BAR; PG8_WAIT_L(0); PG8_MMA(0, 0, At, B0); PG8_BAR; PG8_SCHED;
            PG8_LDB(B1, 1, 1); PG8_STAGE(PG8_SB(1, 0), b3, voffB);
            PG8_BAR; PG8_WAIT_L(0); PG8_MMA(0, 1, At, B1); PG8_BAR;
            PG8_LDA(At, 1, 1); PG8_STAGE(PG8_SA(1, 0), a3, voffA);
            PG8_BAR; PG8_WAIT_L(0); PG8_MMA(1, 0, At, B0); PG8_BAR; PG8_SCHED;
            PG8_STAGE(PG8_SB(1, 1), b3 + hstep, voffB);
            PG8_WAIT_V(6); PG8_BAR; PG8_MMA(1, 1, At, B1); PG8_BAR;
            }
        }
        if constexpr (ALIGN_EPI) { if (wr == 0) PG8_BAR; }
        if constexpr (!Epi::AFTER_DRAIN) { E(acc, cur, wr, wc, fr, fq); S.done(cur); }
        if (!has_next) break;
#pragma unroll
        for (int a = 0; a < 2; ++a)
#pragma unroll
            for (int b = 0; b < 2; ++b)
#pragma unroll
                for (int m = 0; m < 4; ++m)
#pragma unroll
                    for (int n = 0; n < 2; ++n) acc[a][b][m][n] = (f32x4){0.f, 0.f, 0.f, 0.f};
        cur = nxt; cA = nA; cB = nB; ++ui;
        if constexpr (ALIGN_EPI) { if (wr == 1) PG8_BAR; }
    }
    PG8_WAIT_V(0);
    if constexpr (!ALIGN_EPI) { if (wr == 0) PG8_BAR; }
    PG8_BAR;
    if constexpr (Epi::AFTER_DRAIN) { E.fused(acc, cur, wr, wc, fr, fq, lds, wid, lane); S.done(cur); }
#undef PG8_SA
#undef PG8_SB
#undef PG8_STAGE
#undef PG8_LDA
#undef PG8_LDB
#undef PG8_MMA
#undef PG8_WAIT_V
#undef PG8_WAIT_L
#undef PG8_BAR
#undef PG8_SCHED
}
}

#define LAS __attribute__((address_space(3)))
typedef unsigned short bf16_t;
typedef short bf16x8 __attribute__((ext_vector_type(8)));
typedef short s16x4 __attribute__((ext_vector_type(4)));
typedef float f32x4 __attribute__((ext_vector_type(4)));
typedef float f32x2 __attribute__((ext_vector_type(2)));
typedef float f32x16 __attribute__((ext_vector_type(16)));
typedef unsigned u32x4 __attribute__((ext_vector_type(4)));
typedef unsigned u32x2 __attribute__((ext_vector_type(2)));

constexpr int DM = 1024, NB = 8, SEQ = 4096, CTXL = 256, DEPTH = 4;
constexpr int TL = NB * SEQ;
constexpr int TC = NB * CTXL;
constexpr int T = TL + TC;
constexpr int NPM = T / 256;
constexpr int DIN = 9472, NMAIN = 6400;
constexpr float LOG2E = 1.4426950408889634f;
constexpr float QS = 0.125f * LOG2E;

constexpr size_t MiB = 1u << 20;
constexpr size_t SZ_TOK = (size_t)T * 1024 * 2;
constexpr size_t WS_CTL = 0, WS_MODS = 32768, WS_ROPE = WS_MODS + 442368, WS_BS = WS_ROPE + 8192, WS_HC = WS_BS + 2228224;
constexpr size_t WS_WBR = WS_HC + 8388608, WS_WOUT = WS_WBR + 3145728, WS_WIN2 = WS_WOUT + 2097152;
constexpr size_t WS_ZRW = WS_WIN2 + (size_t)7680 * 2048, WS_NAQ = WS_ZRW + (size_t)T * 1792 * 2, WS_DFQ = WS_NAQ + (size_t)T * 1536 * 2;
constexpr size_t WS_G3 = WS_DFQ + (size_t)T * 1536 * 2, WS_HX = WS_G3 + (size_t)T * 1536 * 2;
constexpr size_t WS_WINRW = WS_HX + SZ_TOK;
constexpr size_t WS_END = WS_WINRW + (size_t)1792 * 2048;
constexpr size_t WS_YFB = WS_WINRW, WS_END2 = WS_YFB + SZ_TOK;
constexpr size_t WS_SG = WS_NAQ, WS_MPART = WS_ZRW, WS_YBUF = WS_ZRW + 32 * MiB, WS_M = WS_HX;
static_assert(WS_END2 == 620322816ull && WS_YBUF + SZ_TOK <= WS_NAQ, "workspace map");
constexpr int LDS_BYTES = 147456;
constexpr int NPHASE = 30;

struct Params { const float* in[25]; float* out; unsigned char* ws; int ph_lo, ph_hi, ovl, pad; };
enum { I_X = 0, I_C, I_CTX, I_CCTX, I_WMOD, I_BMOD, I_GPRE, I_GPOST, I_WIN, I_MU, I_KK, I_KA, I_RK, I_W0, I_WUP, I_A0, I_AUP, I_LNG, I_LNB, I_RPB, I_LAMQ, I_LAMK, I_SUBLN, I_WBR, I_WOUT };

__device__ __forceinline__ float bf2f(unsigned u) { return __uint_as_float(u << 16); }
__device__ __forceinline__ unsigned f2bf(float f) { unsigned u = __float_as_uint(f); return (u + 0x7fffu + ((u >> 16) & 1u)) >> 16; }
typedef __bf16 hbf16x2 __attribute__((ext_vector_type(2)));
__device__ __forceinline__ unsigned pk2(float lo, float hi) { f32x2 v = {lo, hi}; hbf16x2 b = __builtin_convertvector(v, hbf16x2); return __builtin_bit_cast(unsigned, b); }
__device__ __forceinline__ float dpp_xor1(float v) { return __int_as_float(__builtin_amdgcn_update_dpp(0, __float_as_int(v), 0xB1, 0xF, 0xF, true)); }
__device__ __forceinline__ float dpp_xor2(float v) { return __int_as_float(__builtin_amdgcn_update_dpp(0, __float_as_int(v), 0x4E, 0xF, 0xF, true)); }
__device__ __forceinline__ float dpp_hmir(float v) { return __int_as_float(__builtin_amdgcn_update_dpp(0, __float_as_int(v), 0x141, 0xF, 0xF, true)); }
__device__ __forceinline__ float sum8(float v) { v += dpp_xor1(v); v += dpp_xor2(v); v += dpp_hmir(v); return v; }
__device__ __forceinline__ float dpp_rmir(float v) { return __int_as_float(__builtin_amdgcn_update_dpp(0, __float_as_int(v), 0x140, 0xF, 0xF, true)); }
__device__ __forceinline__ float xor32_get(float x, int hi) { auto rr = __builtin_amdgcn_permlane32_swap(__float_as_uint(x), __float_as_uint(x), false, false); return __uint_as_float(hi ? rr[0] : rr[1]); }
__device__ __forceinline__ float xor32_sum(float x) { auto rr = __builtin_amdgcn_permlane32_swap(__float_as_uint(x), __float_as_uint(x), false, false); return __uint_as_float(rr[0]) + __uint_as_float(rr[1]); }
__device__ __forceinline__ float xor32_max(float x) { auto rr = __builtin_amdgcn_permlane32_swap(__float_as_uint(x), __float_as_uint(x), false, false); return fmaxf(__uint_as_float(rr[0]), __uint_as_float(rr[1])); }
__device__ __forceinline__ float xor16_sum(float x) { auto rr = __builtin_amdgcn_permlane16_swap(__float_as_uint(x), __float_as_uint(x), false, false); return __uint_as_float(rr[0]) + __uint_as_float(rr[1]); }
__device__ __forceinline__ float wave_sum(float v) { v = sum8(v); v += dpp_rmir(v); v = xor16_sum(v); return xor32_sum(v); }
__device__ __forceinline__ void unpack8(u32x4 w, float* f) {
    f[0] = bf2f(w.x & 0xffffu); f[1] = bf2f(w.x >> 16); f[2] = bf2f(w.y & 0xffffu); f[3] = bf2f(w.y >> 16);
    f[4] = bf2f(w.z & 0xffffu); f[5] = bf2f(w.z >> 16); f[6] = bf2f(w.w & 0xffffu); f[7] = bf2f(w.w >> 16);
}
__device__ __forceinline__ u32x4 pack8(const float* f) { u32x4 w; w.x = pk2(f[0], f[1]); w.y = pk2(f[2], f[3]); w.z = pk2(f[4], f[5]); w.w = pk2(f[6], f[7]); return w; }

struct Sched {
    int mode;
    pg8::StaticOrder so; int G, c, npm;
    const unsigned* ready; unsigned need;
    __device__ __forceinline__ bool next(int i, pg8::Unit& u) const {
        if (mode == 0) return so.next(i, u);
        if (mode == 1) {
            const int k = i / 3, pm = (c & 7) + 8 * (c >> 5) + 64 * k, pn = (c >> 3) & 3;
            if (pm >= npm) return false;
            const int n = i % 3; u.pm = n * NPM + pm; u.pn = n * 4 + pn; return true;
        }
        int pm, pn;
        const int x = c & 7, y = c >> 3;
        if (c >= 32 && i < 2) { const int y1 = y - 4, pe = x + 8 * (y1 >> 2) + 56 * i; pm = pe < 56 ? pe + 8 : pe + 16; pn = y1 & 3; }
        else if (c < 32 && i == 0) { pm = x; pn = y; }
        else if (c >= 32 && c < 96 && i == 2) { const int y2 = y - 4, pl = 8 + x + 8 * (y2 >> 2); pm = pl < 16 ? 56 + pl : 112 + pl; pn = y2 & 3; }
        else return false;
        if (pm >= npm) return false;
        u.pm = pm; u.pn = pn; return true;
    }
    __device__ __forceinline__ void a_ready(const pg8::Unit& u) const {
        if (mode != 2) return;
        if (threadIdx.x < 64) {
            unsigned polls = 0;
            while ((unsigned)__builtin_amdgcn_readfirstlane(__hip_atomic_load(ready + u.pm, __ATOMIC_RELAXED, __HIP_MEMORY_SCOPE_AGENT)) < need) { __builtin_amdgcn_s_sleep(2); if (++polls > (1u << 22)) break; }
            __builtin_amdgcn_fence(__ATOMIC_ACQUIRE, "agent");
            asm volatile("s_waitcnt vmcnt(0)" ::: "memory");
        }
        asm volatile("" ::: "memory"); __builtin_amdgcn_s_barrier(); asm volatile("" ::: "memory");
    }
    __device__ __forceinline__ void done(const pg8::Unit&) const {}
};

struct Epi {
    static constexpr bool PERM = true, AFTER_DRAIN = false;
    int mode, pn_off;
    bf16_t *zrw, *naq, *dfq, *g3, *sg, *mout, *ybuf; float *mpart; const f32x2* rope;
    __device__ __forceinline__ void operator()(const f32x4 (&acc)[2][2][4][2], const pg8::Unit& u, int wr_, int wc_, int fr_, int fq_) const {
        int tq = threadIdx.x; asm volatile("" : "+v"(tq));
        const int lane = tq & 63, wid = tq >> 6, wr = wid >> 2, wc = wid & 3, fr = lane & 15, fq = lane >> 4;
        if (mode <= 1) {
            const int pn = u.pn + pn_off; unsigned char* base; int ldc, colt, act = 0; float scl = 1.f; bool rp = false;
            if (mode == 1) { base = (unsigned char*)sg; ldc = 3072; colt = pn * 256; act = 2; }
            else if (pn < 7) { base = (unsigned char*)zrw; ldc = 1792; colt = pn * 256; }
            else if (pn < 9) { base = (unsigned char*)g3; ldc = 512; colt = (pn - 7) * 256; act = 1; }
            else if (pn < 15) { base = (unsigned char*)naq; ldc = 1536; colt = (pn - 9) * 256; if (pn < 11) scl = QS; }
            else if (pn < 17) { base = (unsigned char*)(g3 + (size_t)T * 512); ldc = 512; colt = (pn - 15) * 256; act = 1; }
            else if (pn < 23) { base = (unsigned char*)dfq; ldc = 1536; colt = (pn - 17) * 256; if (pn < 19) scl = QS; rp = (pn < 21) && (u.pm < 128); }
            else { base = (unsigned char*)(g3 + (size_t)2 * T * 512); ldc = 512; colt = (pn - 23) * 256; act = 1; }
            const int row0 = u.pm * 256 + wr * 64 + fr, col0 = colt + wc * 32 + 8 * fq;
#pragma unroll
            for (int ai = 0; ai < 2; ++ai)
#pragma unroll
                for (int m = 0; m < 4; ++m) {
                    int row = row0 + ai * 128 + m * 16; asm volatile("" : "+v"(row));
                    const unsigned off = ((unsigned)row * (unsigned)ldc + (unsigned)col0) * 2u;
                    float cs[8], sn[8];
                    if (rp) {
                        const int t = row & 4095; const int pos = (wc & 1) ? (t & 63) : (t >> 6);
                        const f32x4* rt = (const f32x4*)(rope + pos * 16 + 8 * (fq & 1));
#pragma unroll
                        for (int e = 0; e < 4; ++e) { const f32x4 q = rt[e]; cs[2 * e] = q.x; sn[2 * e] = q.y; cs[2 * e + 1] = q.z; sn[2 * e + 1] = q.w; }
                    }
#pragma unroll
                    for (int bj = 0; bj < 2; ++bj) {
                        float v[8];
#pragma unroll
                        for (int e = 0; e < 4; ++e) { v[e] = acc[ai][bj][m][0][e]; v[4 + e] = acc[ai][bj][m][1][e]; }
                        if (rp) {
#pragma unroll
                            for (int e = 0; e < 8; ++e) { const float xp = xor32_get(v[e], fq >> 1); v[e] = (fq < 2) ? (v[e] * cs[e] - xp * sn[e]) : (v[e] * cs[e] + xp * sn[e]); }
                        }
                        if (act == 1) {
#pragma unroll
                            for (int e = 0; e < 8; ++e) v[e] = v[e] * __builtin_amdgcn_rcpf(1.f + __expf(-v[e]));
                        } else if (act == 2) {
#pragma unroll
                            for (int e = 0; e < 8; ++e) v[e] = __builtin_amdgcn_rcpf(1.f + __expf(-v[e]));
                        }
#pragma unroll
                        for (int e = 0; e < 8; ++e) v[e] *= scl;
                        *(u32x4*)(base + off + bj * 256) = pack8(v);
                    }
                    asm volatile("" ::: "memory");
                }
        } else if (mode == 2) {
            const int n = u.pn >> 2, pn = u.pn & 3, pm = u.pm - n * NPM;
            bf16_t* part = (bf16_t*)mpart + (size_t)blockIdx.x * 65536;
            const unsigned char* sgb = (const unsigned char*)(sg + (size_t)pm * 256 * 3072 + n * 1024 + pn * 256);
            unsigned char* mb = (unsigned char*)(mout + (size_t)pm * 256 * 1024 + pn * 256);
            const int lr0 = wr * 64 + fr, lc0 = wc * 32 + 8 * fq;
#pragma unroll
            for (int ai = 0; ai < 2; ++ai)
                {
                    int lrb = lr0 + ai * 128; asm volatile("" : "+v"(lrb));
                    u32x4 gq[4][2], pq[4][2];
#pragma unroll
                    for (int mm = 0; mm < 4; ++mm)
#pragma unroll
                        for (int bj = 0; bj < 2; ++bj) {
                            const int lr = lrb + mm * 16, lc = lc0 + bj * 128;
                            gq[mm][bj] = *(const u32x4*)(sgb + ((unsigned)lr * 3072u + (unsigned)lc) * 2u);
                            if (n > 0) pq[mm][bj] = *(const u32x4*)(part + lr * 256 + lc);
                        }
                    asm volatile("" ::: "memory");
#pragma unroll
                    for (int mm = 0; mm < 4; ++mm)
#pragma unroll
                        for (int bj = 0; bj < 2; ++bj) {
                            const int m = mm, lr = lrb + mm * 16, lc = lc0 + bj * 128;
                            float g[8]; unpack8(gq[mm][bj], g);
                            float v[8];
#pragma unroll
                            for (int e = 0; e < 4; ++e) { v[e] = acc[ai][bj][m][0][e] * g[e]; v[4 + e] = acc[ai][bj][m][1][e] * g[4 + e]; }
                            if (n > 0) { float pv_[8]; unpack8(pq[mm][bj], pv_);
#pragma unroll
                                for (int e = 0; e < 8; ++e) v[e] += pv_[e]; }
                            if (n < 2) *(u32x4*)(part + lr * 256 + lc) = pack8(v);
                            else *(u32x4*)(mb + ((unsigned)lr * 1024u + (unsigned)lc) * 2u) = pack8(v);
                        }
                    asm volatile("" ::: "memory");
                }
        } else {
            const int row0 = u.pm * 256 + wr * 64 + fr, col0 = u.pn * 256 + wc * 32 + 8 * fq;
#pragma unroll
            for (int ai = 0; ai < 2; ++ai)
#pragma unroll
                for (int m = 0; m < 4; ++m) {
                    int row = row0 + ai * 128 + m * 16; asm volatile("" : "+v"(row));
                    bf16_t* rowp = ybuf + (size_t)row * 1024 + col0;
#pragma unroll
                    for (int bj = 0; bj < 2; ++bj) { const f32x4 a = acc[ai][bj][m][0], b = acc[ai][bj][m][1];
                        *(u32x4*)(rowp + bj * 128) = (u32x4){pk2(a[0], a[1]), pk2(a[2], a[3]), pk2(b[0], b[1]), pk2(b[2], b[3])}; }
                    asm volatile("" ::: "memory");
                }
        }
    }
};

__device__ __forceinline__ void transpose_item(const float* W, int K, int N, bf16_t* WT, LAS float* scr, int item, int lane) {
    const int nblk = N / 32, kb = item / nblk, nb = item % nblk, k0 = 64 * kb, n0 = 32 * nb;
#pragma unroll 8
    for (int i = 0; i < 32; ++i) { const int kk = 2 * i + (lane >> 5); scr[kk * 33 + (lane & 31)] = W[(size_t)(k0 + kk) * N + n0 + (lane & 31)]; }
    asm volatile("s_waitcnt lgkmcnt(0)" ::: "memory");
    const int c = lane & 7;
#pragma unroll
    for (int j = 0; j < 4; ++j) { const int n = (lane >> 3) + 8 * j; const LAS float* s = scr + (8 * c) * 33 + n;
        u32x4 o; o.x = pk2(s[0 * 33], s[1 * 33]); o.y = pk2(s[2 * 33], s[3 * 33]); o.z = pk2(s[4 * 33], s[5 * 33]); o.w = pk2(s[6 * 33], s[7 * 33]);
        *(u32x4*)(WT + (size_t)(n0 + n) * K + k0 + 8 * c) = o; }
    asm volatile("s_waitcnt lgkmcnt(0)" ::: "memory");
}
__device__ __forceinline__ void convert_weights(const Params& p, int l, unsigned char* lds) {
    const int tid_ = otid(); const int wave = tid_ >> 6, lane = tid_ & 63;
    LAS float* scr = (LAS float*)((LAS unsigned char*)lds + wave * 8704);
    const int gw = blockIdx.x * 8 + wave, NGW = gridDim.x * 8;
    constexpr int I_IN = 16 * (DIN / 32), I_BR = 8 * 32, I_OUT = 16 * 32, NITEMS = I_IN + 3 * I_BR + I_OUT;
    bf16_t* winrw = (bf16_t*)(p.ws + WS_WINRW); bf16_t* win2 = (bf16_t*)(p.ws + WS_WIN2) - (size_t)1792 * 1024; bf16_t* wbr = (bf16_t*)(p.ws + WS_WBR); bf16_t* wout = (bf16_t*)(p.ws + WS_WOUT);
    for (int it = gw; it < NITEMS; it += NGW) {
        int r = it;
        if (r < I_IN) { transpose_item(p.in[I_WIN] + (size_t)l * 1024 * DIN, 1024, DIN, ((r % (DIN / 32)) * 32 < 1792) ? winrw : win2, scr, r, lane); continue; } r -= I_IN;
        if (r < 3 * I_BR) { const int n = r / I_BR; transpose_item(p.in[I_WBR] + ((size_t)l * 3 + n) * 512 * 1024, 512, 1024, wbr + (size_t)n * 1024 * 512, scr, r % I_BR, lane); continue; } r -= 3 * I_BR;
        transpose_item(p.in[I_WOUT] + (size_t)l * 1024 * 1024, 1024, 1024, wout, scr, r, lane);
    }
}

__device__ __forceinline__ void phase_prologue(const Params& p, unsigned char* lds) {
    const int tid = otid(), wave = tid >> 6, lane = tid & 63;
    float* mods = (float*)(p.ws + WS_MODS);
    if (blockIdx.x < 192) {
        float* sc = (float*)lds;
        float* red = (float*)(lds + 36864);
        for (int i = tid; i < 9 * 1024; i += 512) { const float v = (i < 8192) ? p.in[I_C][i] : p.in[I_CCTX][i - 8192]; sc[i] = v / (1.f + __expf(-v)); }
        __syncthreads();
        const int l = blockIdx.x / 48, cb = blockIdx.x % 48, col = cb * 64 + lane;
        const float* W = p.in[I_WMOD] + (size_t)l * 1024 * 3072;
        float a[9];
#pragma unroll
        for (int v = 0; v < 9; ++v) a[v] = 0.f;
        for (int k = wave * 128; k < wave * 128 + 128; ++k) { const float w = W[(size_t)k * 3072 + col];
#pragma unroll
            for (int v = 0; v < 9; ++v) a[v] += sc[v * 1024 + k] * w; }
#pragma unroll
        for (int v = 0; v < 9; ++v) red[(wave * 9 + v) * 64 + lane] = a[v];
        __syncthreads();
        for (int i = tid; i < 9 * 64; i += 512) { const int v = i >> 6, cl = i & 63; float s = 0.f;
#pragma unroll
            for (int w = 0; w < 8; ++w) s += red[(w * 9 + v) * 64 + cl];
            mods[((size_t)l * 9 + v) * 3072 + cb * 64 + cl] = s + p.in[I_BMOD][l * 3072 + cb * 64 + cl]; }
        __syncthreads();
    } else if (blockIdx.x == 192) {
        f32x2* rope = (f32x2*)(p.ws + WS_ROPE);
        for (int i = tid; i < 1024; i += 512) { const int pos = i >> 4, fi = i & 15;
            const float inv = exp2f(-(float)fi * (13.287712379549449f / 16.f));
            const float x = (float)pos * inv; float s, c; sincosf(x, &s, &c); rope[i] = (f32x2){c, s}; }
    }
    convert_weights(p, 0, lds);
}

__device__ __forceinline__ void hx_from_row(const Params& p, int l, int v, const f32x4 (&x)[4], int lane, bf16_t* hxrow) {
    float ss = 0.f;
#pragma unroll
    for (int j = 0; j < 4; ++j) ss += (x[j].x * x[j].x + x[j].y * x[j].y) + (x[j].z * x[j].z + x[j].w * x[j].w);
    const float rx = rsqrtf(wave_sum(ss) * (1.f / 1024.f) + 1e-6f);
    const float* mods = (const float*)(p.ws + WS_MODS) + ((size_t)l * 9 + v) * 3072;
#pragma unroll
    for (int j = 0; j < 4; ++j) { const int c = 4 * lane + 256 * j;
        const f32x4 g = *(const f32x4*)(p.in[I_GPRE] + l * 1024 + c), sh = *(const f32x4*)(mods + c), scv = *(const f32x4*)(mods + 1024 + c);
        const f32x4 h = x[j] * rx * g * (scv + 1.f) + sh;
        u32x2 o; o.x = pk2(h.x, h.y); o.y = pk2(h.z, h.w); *(u32x2*)(hxrow + c) = o; }
}
__device__ __forceinline__ void phase_rowpass(const Params& p, int l) {
    const int tid_ = otid(); const int wave = tid_ >> 6, lane = tid_ & 63;
    const int gw = blockIdx.x * 8 + wave, NGW = gridDim.x * 8;
    const bf16_t* ybuf = (const bf16_t*)(p.ws + WS_YBUF); float* hc = (float*)(p.ws + WS_HC); bf16_t* hx = (bf16_t*)(p.ws + WS_HX);
    const int nrows = (l == DEPTH) ? TL : T;
    constexpr int RP = 4;
#pragma unroll 1
    for (int row0 = gw; row0 < nrows; row0 += RP * NGW) {
        f32x4 x[RP][4], y[RP][4];
#pragma unroll
        for (int q = 0; q < RP; ++q) {
            const int row = min(row0 + q * NGW, nrows - 1); const bool lat = row < TL;
            const float* src = lat ? ((l <= 1 ? p.in[I_X] : (const float*)p.out) + (size_t)row * 1024) : ((l <= 1 ? p.in[I_CTX] : (const float*)hc) + (size_t)(row - TL) * 1024);
#pragma unroll
            for (int j = 0; j < 4; ++j) x[q][j] = __builtin_nontemporal_load((const f32x4*)(src + 4 * lane + 256 * j));
            if (l > 0) {
#pragma unroll
                for (int j = 0; j < 4; ++j) { const u32x2 w = *(const u32x2*)(ybuf + (size_t)row * 1024 + 4 * lane + 256 * j); y[q][j] = (f32x4){bf2f(w.x & 0xffffu), bf2f(w.x >> 16), bf2f(w.y & 0xffffu), bf2f(w.y >> 16)}; }
            }
        }
        asm volatile("" ::: "memory");
#pragma unroll
        for (int q = 0; q < RP; ++q) {
            const int row = row0 + q * NGW;
            if (row < nrows) {
                const bool lat = row < TL; const int v = lat ? (row >> 12) : 8;
                if (l > 0) {
                    float ss = 0.f;
#pragma unroll
                    for (int j = 0; j < 4; ++j) ss += (y[q][j].x * y[q][j].x + y[q][j].y * y[q][j].y) + (y[q][j].z * y[q][j].z + y[q][j].w * y[q][j].w);
                    const float ry = rsqrtf(wave_sum(ss) * (1.f / 1024.f) + 1e-6f);
                    const float* gate = (const float*)(p.ws + WS_MODS) + ((size_t)(l - 1) * 9 + v) * 3072 + 2048;
                    float* dst = lat ? (p.out + (size_t)row * 1024) : (hc + (size_t)(row - TL) * 1024);
#pragma unroll
                    for (int j = 0; j < 4; ++j) { const int c = 4 * lane + 256 * j;
                        const f32x4 gp = *(const f32x4*)(p.in[I_GPOST] + (l - 1) * 1024 + c), gt = *(const f32x4*)(gate + c);
                        x[q][j] = x[q][j] + gt * (y[q][j] * ry * gp); __builtin_nontemporal_store(x[q][j], (f32x4*)(dst + c)); }
                }
                if (l < DEPTH) hx_from_row(p, l, v, x[q], lane, hx + (size_t)row * 1024);
            }
        }
    }
}

__device__ __forceinline__ void phase_readout(const Params& p, int l, bool dynamic) {
    const int tid_ = otid(); const int wave = tid_ >> 6, lane = tid_ & 63;
    const int gw = blockIdx.x * 8 + wave, NGW = gridDim.x * 8;
    bf16_t* hx = (bf16_t*)(p.ws + WS_HX); const bf16_t* yfb = (const bf16_t*)(p.ws + (p.ovl ? WS_YFB : WS_HX)); const bf16_t* zrw = (const bf16_t*)(p.ws + WS_ZRW); bf16_t* g3 = (bf16_t*)(p.ws + WS_G3);
    const float* bs = (const float*)(p.ws + WS_BS); const float* hc = (const float*)(p.ws + WS_HC);
    const int c0 = 8 * lane, head = lane >> 3;
    constexpr int RP = 2;
    auto body = [&](int row0, int qs) {
        u32x4 ryf[RP], ryb[RP], rz[RP], rzp[RP], rzn[RP], rg[RP]; float bsum[RP], fp[RP], fn[RP]; f32x4 x[RP][4];
#pragma unroll
        for (int q = 0; q < RP; ++q) {
            const int row = min(row0 + q * qs, T - 1); const bool lat = row < TL;
            const int tpos = lat ? (row & 4095) : ((row - TL) & 255), slen = lat ? SEQ : CTXL;
            fp[q] = tpos > 0 ? 1.f : 0.f; fn[q] = tpos < slen - 1 ? 1.f : 0.f;
            const size_t rp_ = tpos > 0 ? row - 1 : row, rn_ = tpos < slen - 1 ? row + 1 : row;
            ryf[q] = *(const u32x4*)(yfb + (size_t)row * 1024 + c0); ryb[q] = *(const u32x4*)(yfb + (size_t)row * 1024 + 512 + c0);
            rz[q] = *(const u32x4*)(zrw + (size_t)row * 1792 + 1024 + c0); rzp[q] = *(const u32x4*)(zrw + rp_ * 1792 + 1024 + c0); rzn[q] = *(const u32x4*)(zrw + rn_ * 1792 + 1024 + c0);
            rg[q] = *(const u32x4*)(g3 + (size_t)row * 512 + c0);
            bsum[q] = bs[(size_t)row * 8 + head] + bs[((size_t)T + row) * 8 + head];
            if (!p.ovl) {
                const float* src = lat ? ((l == 0 ? p.in[I_X] : (const float*)p.out) + (size_t)row * 1024) : ((l == 0 ? p.in[I_CTX] : hc) + (size_t)(row - TL) * 1024);
#pragma unroll
                for (int j = 0; j < 4; ++j) x[q][j] = *(const f32x4*)(src + 4 * lane + 256 * j);
            } else {
#pragma unroll
                for (int j = 0; j < 4; ++j) x[q][j] = (f32x4){0.f, 0.f, 0.f, 0.f};
            }
        }
        asm volatile("" ::: "memory");
#pragma unroll
        for (int q = 0; q < RP; ++q) {
            const int row = row0 + q * qs;
            if (row < T) {
                const bool lat = row < TL; const int v = lat ? (row >> 12) : 8;
                float yf[8], yb[8], z[8], zp[8], zn[8], g[8];
                unpack8(ryf[q], yf); unpack8(ryb[q], yb); unpack8(rz[q], z); unpack8(rzp[q], zp); unpack8(rzn[q], zn); unpack8(rg[q], g);
                float y[8], sacc = 0.f;
#pragma unroll
                for (int e = 0; e < 8; ++e) { y[e] = yf[e] + yb[e]; sacc += y[e]; }
                const float mu = sum8(sacc) * (1.f / 64.f); float qq = 0.f;
#pragma unroll
                for (int e = 0; e < 8; ++e) { y[e] -= mu; qq += y[e] * y[e]; }
                const float rs = rsqrtf(sum8(qq) * (1.f / 64.f) + 64e-5f);
                const f32x4 lg0 = *(const f32x4*)(p.in[I_LNG] + l * 512 + c0), lg1 = *(const f32x4*)(p.in[I_LNG] + l * 512 + c0 + 4);
                const f32x4 lb0 = *(const f32x4*)(p.in[I_LNB] + l * 512 + c0), lb1 = *(const f32x4*)(p.in[I_LNB] + l * 512 + c0 + 4);
                const float* mup = p.in[I_MU] + (size_t)(l * 2 + 0) * 1792 + 1024 + c0; const float* mun = p.in[I_MU] + (size_t)(l * 2 + 1) * 1792 + 1024 + c0;
                const f32x4 mp0 = *(const f32x4*)mup, mp1 = *(const f32x4*)(mup + 4), mn0 = *(const f32x4*)mun, mn1 = *(const f32x4*)(mun + 4);
                float o[8];
#pragma unroll
                for (int e = 0; e < 8; ++e) {
                    const float lg = e < 4 ? lg0[e & 3] : lg1[e & 3], lb = e < 4 ? lb0[e & 3] : lb1[e & 3], mp = e < 4 ? mp0[e & 3] : mp1[e & 3], mn = e < 4 ? mn0[e & 3] : mn1[e & 3];
                    const float vv = z[e] + mp * (fp[q] * zp[e] - z[e]) + mn * (fn[q] * zn[e] - z[e]);
                    o[e] = (y[e] * rs * lg + lb + bsum[q] * vv) * g[e];
                }
                *(u32x4*)(g3 + (size_t)row * 512 + c0) = pack8(o);
                if (!p.ovl) hx_from_row(p, l, v, x[q], lane, hx + (size_t)row * 1024);
            }
        }
    };
    if (!dynamic) {
#pragma unroll 1
        for (int row0 = gw; row0 < T; row0 += RP * NGW) body(row0, NGW);
    } else {
        unsigned* ctr = (unsigned*)(p.ws + WS_CTL) + 64 * (48 + l);
#pragma unroll 1
        for (;;) {
            int c = 0;
            if (lane == 0) c = (int)atomicAdd(ctr, 1u);
            c = __builtin_amdgcn_readfirstlane(c);
            if (c >= T / 16) break;
#pragma unroll 1
            for (int k = 0; k < 8; ++k) body(16 * c + 2 * k, 1);
        }
    }
}

constexpr int SC_BUF = 0, SC_BUFSZ = 49152, SC_YL = 98304, SC_YLSZ = 8192, SC_WT = 114688, SC_XS = 133120, SC_XSSZ = 2304, SC_CST = 142336;
struct ScanRaw { u32x4 q[5][3]; };
__device__ __forceinline__ void scan_chain(const Params& p, int l, int chain, unsigned char* lds) {
    const int tid = otid(), wave = __builtin_amdgcn_readfirstlane(tid >> 6), lane = tid & 63, hi = lane >> 5;
    const int b = chain >> 4, h = (chain >> 1) & 7, dir = chain & 1;
    const bf16_t* zrw = (const bf16_t*)(p.ws + WS_ZRW); bf16_t* yfb = (bf16_t*)(p.ws + (p.ovl ? WS_YFB : WS_HX)); float* bs = (float*)(p.ws + WS_BS);
    unsigned char* wt = lds + SC_WT;
    { const float* wu = p.in[I_WUP] + ((size_t)(l * 2 + dir) * 64) * 512 + h * 64; const float* au = p.in[I_AUP] + ((size_t)(l * 2 + dir) * 64) * 512 + h * 64;
      for (int idx = tid; idx < 8192; idx += 512) { const int m = idx >> 12, i = (idx >> 6) & 63, j = idx & 63;
          const float v = (m ? au : wu)[(size_t)i * 512 + j]; *(bf16_t*)(wt + (m * 64 + j) * 144 + i * 2) = (bf16_t)f2bf(v); } }
    float* cst = (float*)(lds + SC_CST);
    for (int idx = tid; idx < 15 * 64; idx += 512) { const int q = idx >> 6, j = idx & 63; float v;
        if (q == 0) v = p.in[I_W0][(l * 2 + dir) * 512 + h * 64 + j]; else if (q == 1) v = p.in[I_A0][(l * 2 + dir) * 512 + h * 64 + j];
        else if (q == 2) v = p.in[I_KK][l * 512 + h * 64 + j]; else if (q == 3) v = p.in[I_KA][l * 512 + h * 64 + j]; else if (q == 4) v = p.in[I_RK][l * 512 + h * 64 + j];
        else { const int g = (q - 5) % 5, nx = (q - 5) / 5; const int col = g < 3 ? g * 512 + h * 64 + j : (g == 3 ? 1536 : 1664) + dir * 64 + j; v = p.in[I_MU][(size_t)(l * 2 + nx) * 1792 + col]; }
        cst[idx] = v; }
    constexpr int NC = (CTXL + SEQ) / 32;
    const int pw = wave - 4, tl = lane >> 3, jg = lane & 7, ch0 = h * 64 + 8 * jg;
    const int colq[5] = {ch0, 512 + ch0, 1024 + ch0, 1536 + dir * 64 + 8 * jg, 1664 + dir * 64 + 8 * jg};
    auto chunk_pos = [&](int c, int& len, size_t& rbase, int& t0) {
        const bool cx = c < CTXL / 32; len = cx ? CTXL : SEQ; rbase = cx ? (size_t)TL + b * CTXL : (size_t)b * SEQ;
        const int ci = cx ? c : c - CTXL / 32; t0 = dir == 0 ? ci * 32 : len - 32 * (ci + 1);
    };
    auto load_raw = [&](int c, ScanRaw& R) {
        int len, t0; size_t rbase; chunk_pos(c, len, rbase, t0);
        int ln_ = lane; asm volatile("" : "+v"(ln_)); const int tl = ln_ >> 3, jg = ln_ & 7, ch0 = h * 64 + 8 * jg;
        const int colq[5] = {ch0, 512 + ch0, 1024 + ch0, 1536 + dir * 64 + 8 * jg, 1664 + dir * 64 + 8 * jg};
        const int t = t0 + 8 * pw + tl; const size_t row = rbase + t;
        const size_t rp = t > 0 ? row - 1 : row, rn = t < len - 1 ? row + 1 : row;
#pragma unroll
        for (int qn = 0; qn < 5; ++qn) { R.q[qn][0] = *(const u32x4*)(zrw + row * 1792 + colq[qn]); R.q[qn][1] = *(const u32x4*)(zrw + rp * 1792 + colq[qn]); R.q[qn][2] = *(const u32x4*)(zrw + rn * 1792 + colq[qn]); }
    };
    auto process = [&](int c, ScanRaw& R, int cnext) {
        int len, t0; size_t rbase; chunk_pos(c, len, rbase, t0);
        int ln_ = lane; asm volatile("" : "+v"(ln_)); const int tl = ln_ >> 3, jg = ln_ & 7, hi = ln_ >> 5, lane = ln_;
        const int tch = 8 * pw + tl, t = t0 + tch; const size_t row = rbase + t;
        const float fp = t > 0 ? 1.f : 0.f, fn = t < len - 1 ? 1.f : 0.f;
        float us[5][8];
#pragma unroll
        for (int qn = 0; qn < 5; ++qn) {
            float z[8], zp[8], zn[8]; unpack8(R.q[qn][0], z); unpack8(R.q[qn][1], zp); unpack8(R.q[qn][2], zn);
            const float* mup = cst + (5 + qn) * 64 + 8 * jg; const float* mun = cst + (10 + qn) * 64 + 8 * jg;
            const f32x4 mp0 = *(const f32x4*)mup, mp1 = *(const f32x4*)(mup + 4), mn0 = *(const f32x4*)mun, mn1 = *(const f32x4*)(mun + 4);
#pragma unroll
            for (int e = 0; e < 8; ++e) { const float mp = e < 4 ? mp0[e & 3] : mp1[e & 3], mn = e < 4 ? mn0[e & 3] : mn1[e & 3];
                us[qn][e] = z[e] + mp * (fp * zp[e] - z[e]) + mn * (fn * zn[e] - z[e]); }
        }
        asm volatile("" ::: "memory");
        if (cnext < NC) load_raw(cnext, R);
        unsigned char* xs = lds + SC_XS + pw * SC_XSSZ;
        { float tw[8];
#pragma unroll
          for (int e = 0; e < 8; ++e) { const float ex = __expf(2.f * us[3][e]); tw[e] = 1.f - 2.f * __builtin_amdgcn_rcpf(ex + 1.f); }
          *(u32x4*)(xs + (0 * 8 + tl) * 144 + jg * 16) = pack8(tw); *(u32x4*)(xs + (1 * 8 + tl) * 144 + jg * 16) = pack8(us[4]); }
        asm volatile("s_waitcnt lgkmcnt(0)" ::: "memory");
        float* arr = (float*)(lds + SC_BUF + (c & 1) * SC_BUFSZ);
#pragma unroll
        for (int m = 0; m < 2; ++m)
#pragma unroll
            for (int nb = 0; nb < 2; ++nb) {
                f32x16 acc = {};
#pragma unroll
                for (int ks = 0; ks < 4; ++ks) {
                    const bf16x8 A = *(const bf16x8*)(xs + (m * 8 + (lane & 7)) * 144 + (16 * ks + 8 * hi) * 2);
                    const bf16x8 B = *(const bf16x8*)(wt + (m * 64 + 32 * nb + (lane & 31)) * 144 + (16 * ks + 8 * hi) * 2);
                    acc = __builtin_amdgcn_mfma_f32_32x32x16_bf16(A, B, acc, 0, 0, 0);
                }
                float* dst = arr + (m == 0 ? 0 : 3) * 2048 + (8 * pw + 4 * hi) * 64 + 32 * nb + (lane & 31);
                dst[0] = acc[0]; dst[64] = acc[1]; dst[128] = acc[2]; dst[192] = acc[3];
            }
        asm volatile("s_waitcnt lgkmcnt(0)" ::: "memory");
        float* a0p = arr + tch * 64 + 8 * jg;
        float wl[8], al[8];
        { const f32x4 a0 = *(const f32x4*)(a0p), a1 = *(const f32x4*)(a0p + 4), b0 = *(const f32x4*)(a0p + 3 * 2048), b1 = *(const f32x4*)(a0p + 3 * 2048 + 4);
#pragma unroll
          for (int e = 0; e < 4; ++e) { wl[e] = a0[e]; wl[4 + e] = a1[e]; al[e] = b0[e]; al[4 + e] = b1[e]; } }
        float dec[8], kd[8], bv[8], kk[8], av[8]; float n2 = 0.f, bon = 0.f;
        const float* c_w0 = cst + 0 * 64 + 8 * jg; const float* c_a0 = cst + 1 * 64 + 8 * jg;
        const float* c_kk = cst + 2 * 64 + 8 * jg; const float* c_ka = cst + 3 * 64 + 8 * jg; const float* c_rk = cst + 4 * 64 + 8 * jg;
#pragma unroll
        for (int e = 0; e < 8; ++e) {
            const float xw = c_w0[e] + wl[e];
            const float sp = fmaxf(-xw, 0.f) + __logf(1.f + __expf(-fabsf(xw)));
            dec[e] = __expf(-__expf(-sp - 0.5f));
            const float a = __builtin_amdgcn_rcpf(1.f + __expf(-(c_a0[e] + al[e])));
            kk[e] = us[1][e] * c_kk[e]; n2 += kk[e] * kk[e];
            kd[e] = us[1][e] * (1.f + (a - 1.f) * c_ka[e]);
            bon += us[0][e] * kd[e] * c_rk[e];
            av[e] = a;
        }
        n2 = sum8(n2); bon = sum8(bon);
        const float rn = 1.f / fmaxf(sqrtf(n2), 1e-12f);
#pragma unroll
        for (int e = 0; e < 8; ++e) { kk[e] *= rn; bv[e] = kk[e] * av[e]; kk[e] = -kk[e]; }
        *(f32x4*)(a0p + 0 * 2048) = (f32x4){dec[0], dec[1], dec[2], dec[3]}; *(f32x4*)(a0p + 0 * 2048 + 4) = (f32x4){dec[4], dec[5], dec[6], dec[7]};
        *(f32x4*)(a0p + 1 * 2048) = (f32x4){kd[0], kd[1], kd[2], kd[3]};     *(f32x4*)(a0p + 1 * 2048 + 4) = (f32x4){kd[4], kd[5], kd[6], kd[7]};
        *(f32x4*)(a0p + 2 * 2048) = (f32x4){kk[0], kk[1], kk[2], kk[3]};     *(f32x4*)(a0p + 2 * 2048 + 4) = (f32x4){kk[4], kk[5], kk[6], kk[7]};
        *(f32x4*)(a0p + 3 * 2048) = (f32x4){bv[0], bv[1], bv[2], bv[3]};     *(f32x4*)(a0p + 3 * 2048 + 4) = (f32x4){bv[4], bv[5], bv[6], bv[7]};
        *(f32x4*)(a0p + 4 * 2048) = (f32x4){us[0][0], us[0][1], us[0][2], us[0][3]}; *(f32x4*)(a0p + 4 * 2048 + 4) = (f32x4){us[0][4], us[0][5], us[0][6], us[0][7]};
        *(f32x4*)(a0p + 5 * 2048) = (f32x4){us[2][0], us[2][1], us[2][2], us[2][3]}; *(f32x4*)(a0p + 5 * 2048 + 4) = (f32x4){us[2][4], us[2][5], us[2][6], us[2][7]};
        if (jg == 0) bs[((size_t)dir * T + row) * 8 + h] = bon;
    };
    auto flush = [&](int c) {
        int len, t0; size_t rbase; chunk_pos(c, len, rbase, t0);
        int ln_ = lane; asm volatile("" : "+v"(ln_)); const int tl = ln_ >> 3, jg = ln_ & 7, ch0 = h * 64 + 8 * jg;
        const int tch = 8 * pw + tl; const size_t row = rbase + t0 + tch;
        const float* yl = (const float*)(lds + SC_YL + (c & 1) * SC_YLSZ) + tch * 64 + 8 * jg;
        const f32x4 y0 = *(const f32x4*)yl, y1 = *(const f32x4*)(yl + 4);
        u32x4 o; o.x = pk2(y0[0], y0[1]); o.y = pk2(y0[2], y0[3]); o.z = pk2(y1[0], y1[1]); o.w = pk2(y1[2], y1[3]);
        *(u32x4*)(yfb + row * 1024 + dir * 512 + ch0) = o;
    };
    const int rp = lane >> 3, cgp = lane & 7, i0 = 16 * wave + rp, i1 = i0 + 8;
    f32x2 S0[4], S1[4];
#pragma unroll
    for (int e = 0; e < 4; ++e) { S0[e] = (f32x2){0.f, 0.f}; S1[e] = (f32x2){0.f, 0.f}; }
    ScanRaw R;
    __syncthreads();
    if (wave >= 4) { load_raw(0, R); process(0, R, 1); }
    __syncthreads();
#pragma unroll 1
    for (int c = 0; c < NC; ++c) {
        if (wave < 4) {
            const float* arr = (const float*)(lds + SC_BUF + (c & 1) * SC_BUFSZ);
            float* yl = (float*)(lds + SC_YL + (c & 1) * SC_YLSZ);
            struct StepIn { f32x4 w0, w1, k0, k1, a0, a1, b0, b1, r0, r1; float v0, v1; };
            auto ld = [&](int s, StepIn& I) {
                const int ts = dir == 0 ? s : 31 - s; const float* ap = arr + ts * 64 + 8 * cgp;
                I.w0 = *(const f32x4*)(ap); I.w1 = *(const f32x4*)(ap + 4); I.k0 = *(const f32x4*)(ap + 2048); I.k1 = *(const f32x4*)(ap + 2048 + 4);
                I.a0 = *(const f32x4*)(ap + 4096); I.a1 = *(const f32x4*)(ap + 4096 + 4); I.b0 = *(const f32x4*)(ap + 6144); I.b1 = *(const f32x4*)(ap + 6144 + 4);
                I.r0 = *(const f32x4*)(ap + 8192); I.r1 = *(const f32x4*)(ap + 8192 + 4);
                I.v0 = arr[5 * 2048 + ts * 64 + i0]; I.v1 = arr[5 * 2048 + ts * 64 + i1];
            };
            auto comp = [&](int s, const StepIn& I) {
                const int ts = dir == 0 ? s : 31 - s;
                const f32x2 w[4] = {{I.w0[0], I.w0[1]}, {I.w0[2], I.w0[3]}, {I.w1[0], I.w1[1]}, {I.w1[2], I.w1[3]}};
                const f32x2 k[4] = {{I.k0[0], I.k0[1]}, {I.k0[2], I.k0[3]}, {I.k1[0], I.k1[1]}, {I.k1[2], I.k1[3]}};
                const f32x2 a[4] = {{I.a0[0], I.a0[1]}, {I.a0[2], I.a0[3]}, {I.a1[0], I.a1[1]}, {I.a1[2], I.a1[3]}};
                const f32x2 bb[4] = {{I.b0[0], I.b0[1]}, {I.b0[2], I.b0[3]}, {I.b1[0], I.b1[1]}, {I.b1[2], I.b1[3]}};
                const f32x2 r[4] = {{I.r0[0], I.r0[1]}, {I.r0[2], I.r0[3]}, {I.r1[0], I.r1[1]}, {I.r1[2], I.r1[3]}};
                f32x2 d0 = S0[0] * a[0] + S0[1] * a[1], d0b = S0[2] * a[2] + S0[3] * a[3];
                f32x2 d1 = S1[0] * a[0] + S1[1] * a[1], d1b = S1[2] * a[2] + S1[3] * a[3];
                d0 += d0b; d1 += d1b;
                const float sa0 = sum8(d0.x + d0.y), sa1 = sum8(d1.x + d1.y);
#pragma unroll
                for (int e = 0; e < 4; ++e) { S0[e] = S0[e] * w[e] + bb[e] * sa0 + k[e] * I.v0; S1[e] = S1[e] * w[e] + bb[e] * sa1 + k[e] * I.v1; }
                f32x2 y0 = S0[0] * r[0] + S0[1] * r[1], y0b = S0[2] * r[2] + S0[3] * r[3];
                f32x2 y1 = S1[0] * r[0] + S1[1] * r[1], y1b = S1[2] * r[2] + S1[3] * r[3];
                y0 += y0b; y1 += y1b;
                const float ya = sum8(y0.x + y0.y), yb = sum8(y1.x + y1.y);
                if (cgp == 0) { yl[ts * 64 + i0] = ya; yl[ts * 64 + i1] = yb; }
            };
            __builtin_amdgcn_s_setprio(3);
            StepIn IA, IB;
            ld(0, IA);
#pragma unroll 1
            for (int s = 0; s < 32; s += 2) {
                ld(s + 1, IB);
                comp(s, IA);
                if (s + 2 < 32) ld(s + 2, IA);
                comp(s + 1, IB);
            }
            __builtin_amdgcn_s_setprio(0);
        } else {
            if (c > 0) flush(c - 1);
            if (c + 1 < NC) process(c + 1, R, c + 2);
        }
        __syncthreads();
    }
    if (wave >= 4) flush(NC - 1);
    __syncthreads();
}

__device__ __forceinline__ s16x4 tr_read(const unsigned char* pgen) {
    return __builtin_bit_cast(s16x4, __builtin_amdgcn_ds_read_tr16_b64_v4i16((LAS s16x4*)(uintptr_t)(unsigned)(uintptr_t)pgen));
}
__device__ __forceinline__ float max3f_(float a, float b, float c) { float r; asm("v_max3_f32 %0, %1, %2, %3" : "=v"(r) : "v"(a), "v"(b), "v"(c)); return r; }
template <int KW, int DV, bool NA>
__device__ __forceinline__ void attn_loop(unsigned char* lds, const bf16_t* Kg, const bf16_t* Vg, int pitch,
                                          int n1, size_t base1, int ntile, size_t base2,
                                          const bf16x8 (&qf)[4], int kcoff, int act_lo, int act_hi,
                                          int na_r, int na_c, int na_row0, const float* rpbs,
                                          f32x16 (&o)[DV / 32], float& l_out) {
    constexpr int KSTR = KW * 2 + 16, VSTR = DV * 2 + 64, KCH = KW / 8, VCH = DV / 8, NK = KW / 64, NV = DV / 64;
    constexpr int STAGE = 64 * KSTR + 64 * VSTR;
    const int tid = otid(), lane = tid & 63, q32 = lane & 31, hi = lane >> 5;
    const bool gB = (tid >> 8) != 0;
    u32x4 kA[NK], vA[NV], kB[NK], vB[NV];
    auto rowbase = [&](int i) -> size_t { return i < n1 ? base1 + (size_t)64 * i : base2 + (size_t)64 * (i - n1); };
    auto prefetch = [&](int i, u32x4 (&kreg)[NK], u32x4 (&vreg)[NV]) {
        const size_t rb = rowbase(i);
#pragma unroll
        for (int e = 0; e < NK; ++e) { const int c = tid + 512 * e; kreg[e] = *(const u32x4*)(Kg + (rb + c / KCH) * pitch + (c % KCH) * 8); }
#pragma unroll
        for (int e = 0; e < NV; ++e) { const int c = tid + 512 * e; vreg[e] = *(const u32x4*)(Vg + (rb + c / VCH) * pitch + (c % VCH) * 8); }
    };
    auto stash = [&](int st, const u32x4 (&kreg)[NK], const u32x4 (&vreg)[NV]) {
        unsigned char* Kt = lds + st * STAGE; unsigned char* Vt = Kt + 64 * KSTR;
#pragma unroll
        for (int e = 0; e < NK; ++e) { const int c = tid + 512 * e; *(u32x4*)(Kt + (c / KCH) * KSTR + (c % KCH) * 16) = kreg[e]; }
#pragma unroll
        for (int e = 0; e < NV; ++e) { const int c = tid + 512 * e; *(u32x4*)(Vt + (c / VCH) * VSTR + (c % VCH) * 16) = vreg[e]; }
    };
    float m_ref = 0.f, l_run = 0.f; bool first = true;
    u32x4 pw[4];
    f32x16 negm = {}; asm volatile("" : "+v"(negm));
#pragma unroll
    for (int d = 0; d < DV / 32; ++d) o[d] = (f32x16){};
    auto is_active = [&](int i) -> bool { return (i >= n1) || (i >= act_lo && i < act_hi); };
    auto tile = [&](int i, const unsigned char* Kt, const unsigned char* Vt) {
        constexpr int DT = DV / 32;
        f32x16 p0, p1;
#pragma unroll
        for (int d0 = 0; d0 < 4; ++d0) {
            const bf16x8 a0 = *(const bf16x8*)(Kt + q32 * KSTR + (kcoff + 16 * d0 + 8 * hi) * 2);
            const bf16x8 a1 = *(const bf16x8*)(Kt + (32 + q32) * KSTR + (kcoff + 16 * d0 + 8 * hi) * 2);
            if (d0 == 0) { p0 = __builtin_amdgcn_mfma_f32_32x32x16_bf16(a0, qf[0], negm, 0, 0, 0); p1 = __builtin_amdgcn_mfma_f32_32x32x16_bf16(a1, qf[0], negm, 0, 0, 0); }
            else { p0 = __builtin_amdgcn_mfma_f32_32x32x16_bf16(a0, qf[d0], p0, 0, 0, 0); p1 = __builtin_amdgcn_mfma_f32_32x32x16_bf16(a1, qf[d0], p1, 0, 0, 0); }
        }
        if (NA && i < n1) {
            const int kr = na_row0 + i, dr = kr - na_r + 7;
            const int cs = min(max(na_c - 8, 0), 48);
            const float* rb = rpbs + dr * 31 - na_c + 15;
#pragma unroll
            for (int r = 0; r < 16; ++r) {
                const int kc0 = (r & 3) + 8 * (r >> 2) + 4 * hi, kc1 = kc0 + 32;
                const bool ok0 = (kc0 >= cs) && (kc0 < cs + 16), ok1 = (kc1 >= cs) && (kc1 < cs + 16);
                p0[r] = ok0 ? p0[r] + rb[kc0] : -1e30f;
                p1[r] = ok1 ? p1[r] + rb[kc1] : -1e30f;
            }
        }
        asm volatile("s_nop 15\n\ts_nop 7" : "+v"(p0), "+v"(p1));
        float mxa = max3f_(p0[0], p0[1], p1[0]), mxb = max3f_(p0[2], p0[3], p1[1]);
        mxa = max3f_(mxa, p1[2], p1[3]);
#pragma unroll
        for (int r = 4; r < 16; r += 4) { mxa = max3f_(mxa, p0[r], p0[r + 1]); mxb = max3f_(mxb, p0[r + 2], p0[r + 3]); mxa = max3f_(mxa, p1[r], p1[r + 1]); mxb = max3f_(mxb, p1[r + 2], p1[r + 3]); }
        float mx = max3f_(mxa, mxb, mxb);
        mx = xor32_max(mx);
        if (first || __any(mx > 6.f)) {
            const float dl = first ? mx : fmaxf(mx, 0.f);
            const float f = first ? 0.f : __builtin_amdgcn_exp2f(-dl);
            m_ref += dl; l_run *= f;
#pragma unroll
            for (int r = 0; r < 16; ++r) negm[r] = -m_ref;
            asm volatile("" : "+v"(negm));
#pragma unroll
            for (int r = 0; r < 16; ++r) { p0[r] -= dl; p1[r] -= dl; }
#pragma unroll
            for (int d = 0; d < DT; ++d)
#pragma unroll
                for (int r = 0; r < 16; ++r) o[d][r] *= f;
            first = false;
        }
        const unsigned vb = (unsigned)(uintptr_t)(Vt + (4 * hi + ((lane & 15) >> 2)) * VSTR + (16 * ((lane >> 4) & 1) + 4 * (lane & 3)) * 2);
        s16x4 lo[DT], hh[DT];
#define TR_ISSUE(KS, d) do { \
            asm volatile("ds_read_b64_tr_b16 %0, %1 offset:%c2" : "=&v"(lo[d]) : "v"(vb), "i"((16 * (KS)) * VSTR + 64 * (d)) : "memory"); \
            asm volatile("ds_read_b64_tr_b16 %0, %1 offset:%c2" : "=&v"(hh[d]) : "v"(vb), "i"((16 * (KS) + 8) * VSTR + 64 * (d)) : "memory"); } while (0)
#define PV_VF(d) ((bf16x8){lo[d][0], lo[d][1], lo[d][2], lo[d][3], hh[d][0], hh[d][1], hh[d][2], hh[d][3]})
#define LGKM_WAIT(N) do { if constexpr ((N) == 6) asm volatile("s_waitcnt lgkmcnt(6)" ::: "memory"); else if constexpr ((N) == 4) asm volatile("s_waitcnt lgkmcnt(4)" ::: "memory"); \
            else if constexpr ((N) == 2) asm volatile("s_waitcnt lgkmcnt(2)" ::: "memory"); else asm volatile("s_waitcnt lgkmcnt(0)" ::: "memory"); __builtin_amdgcn_sched_barrier(0); } while (0)
#define SM_SLICE(P, LO, HI) _Pragma("unroll") for (int r = (LO); r < (HI); ++r) { P[r] = __builtin_amdgcn_exp2f(P[r]); ps += P[r]; }
#define PACK8(P, B) ((u32x4){pk2(P[(B)], P[(B) + 1]), pk2(P[(B) + 2], P[(B) + 3]), pk2(P[(B) + 4], P[(B) + 5]), pk2(P[(B) + 6], P[(B) + 7])})
#pragma unroll
        for (int d = 0; d < DT; ++d) TR_ISSUE(0, d);
        float ps = 0.f;
        SM_SLICE(p0, 0, 8); pw[0] = PACK8(p0, 0);
#pragma unroll
        for (int d = 0; d < DT; ++d) {
            LGKM_WAIT(2 * (DT - 1));
            o[d] = __builtin_amdgcn_mfma_f32_32x32x16_bf16(PV_VF(d), __builtin_bit_cast(bf16x8, pw[0]), o[d], 0, 0, 0);
            TR_ISSUE(1, d);
            SM_SLICE(p0, 8 + d * (8 / DT), 8 + (d + 1) * (8 / DT));
            __builtin_amdgcn_sched_barrier(0);
        }
        pw[1] = PACK8(p0, 8);
#pragma unroll
        for (int d = 0; d < DT; ++d) {
            LGKM_WAIT(2 * (DT - 1));
            o[d] = __builtin_amdgcn_mfma_f32_32x32x16_bf16(PV_VF(d), __builtin_bit_cast(bf16x8, pw[1]), o[d], 0, 0, 0);
            TR_ISSUE(2, d);
            SM_SLICE(p1, d * (8 / DT), (d + 1) * (8 / DT));
            __builtin_amdgcn_sched_barrier(0);
        }
        pw[2] = PACK8(p1, 0);
#pragma unroll
        for (int d = 0; d < DT; ++d) {
            LGKM_WAIT(2 * (DT - 1));
            o[d] = __builtin_amdgcn_mfma_f32_32x32x16_bf16(PV_VF(d), __builtin_bit_cast(bf16x8, pw[2]), o[d], 0, 0, 0);
            TR_ISSUE(3, d);
            SM_SLICE(p1, 8 + d * (8 / DT), 8 + (d + 1) * (8 / DT));
            __builtin_amdgcn_sched_barrier(0);
        }
        pw[3] = PACK8(p1, 8);
        l_run += ps;
        asm volatile("s_waitcnt lgkmcnt(0)" ::: "memory"); __builtin_amdgcn_sched_barrier(0);
#pragma unroll
        for (int d = 0; d < DT; ++d) o[d] = __builtin_amdgcn_mfma_f32_32x32x16_bf16(PV_VF(d), __builtin_bit_cast(bf16x8, pw[3]), o[d], 0, 0, 0);
#undef TR_ISSUE
#undef PV_VF
#undef LGKM_WAIT
#undef SM_SLICE
#undef PACK8
    };
    prefetch(0, kA, vA); stash(0, kA, vA);
    if (ntile > 1) prefetch(1, kB, vB);
    if (ntile > 2) prefetch(2, kA, vA);
    __syncthreads();
    int st_cur = 0, st_prev = 2, st_next = 1;
    auto step = [&](int i, u32x4 (&kreg)[NK], u32x4 (&vreg)[NV]) {
        if (i + 1 < ntile) { stash(st_next, kreg, vreg); if (i + 3 < ntile) prefetch(i + 3, kreg, vreg); }
        const unsigned char* Kt = lds + st_cur * STAGE;
        if (is_active(i)) tile(i, Kt, Kt + 64 * KSTR);
        __syncthreads();
        const int t_ = st_prev; st_prev = st_cur; st_cur = st_next; st_next = t_;
    };
#pragma unroll 1
    for (int i = 0; i < ntile; i += 2) { step(i, kB, vB); if (i + 1 < ntile) step(i + 1, kA, vA); }
    l_out = xor32_sum(l_run);
}

constexpr int AT_X1 = 0, AT_RPB = 114688, AT_SLOT = 117760;
__device__ __forceinline__ void diff_unit(const Params& p, int l, int b, int h, size_t qrow0, int tile_lo, unsigned char* lds) {
    const int tid = otid(), wave = tid >> 6, lane = tid & 63, q32 = lane & 31, hi = lane >> 5, qg = wave >> 1, m = wave & 1;
    const bf16_t* dfq = (const bf16_t*)(p.ws + WS_DFQ); bf16_t* gout = (bf16_t*)(p.ws + WS_G3) + (size_t)2 * T * 512;
    const size_t qrow = qrow0 + qg * 32 + q32;
    bf16x8 qf[4];
#pragma unroll
    for (int d0 = 0; d0 < 4; ++d0) qf[d0] = *(const bf16x8*)(dfq + qrow * 1536 + h * 128 + m * 64 + 16 * d0 + 8 * hi);
    f32x16 o[4]; float lsum;
    const int n1 = 64 - tile_lo;
    attn_loop<128, 128, false>(lds, dfq + 512 + h * 128, dfq + 1024 + h * 128, 1536, n1, (size_t)b * SEQ, n1 + 4, (size_t)TL + b * CTXL,
                               qf, m * 64, 0, n1, 0, 0, 0, nullptr, o, lsum);
    const float il = 1.f / lsum;
    float* x1 = (float*)(lds + AT_X1) + qg * 4096;
    if (m == 1) {
#pragma unroll
        for (int d = 0; d < 4; ++d)
#pragma unroll
            for (int r = 0; r < 16; ++r) x1[(32 * d + (r & 3) + 8 * (r >> 2) + 4 * hi) * 32 + q32] = o[d][r] * il;
    }
    __syncthreads();
    if (m == 0) {
        float lam;
        { const float a = p.in[I_LAMQ][(l * 2 + 0) * 64 + lane] * p.in[I_LAMK][(l * 2 + 0) * 64 + lane], c = p.in[I_LAMQ][(l * 2 + 1) * 64 + lane] * p.in[I_LAMK][(l * 2 + 1) * 64 + lane];
          lam = __expf(wave_sum(a)) - __expf(wave_sum(c)); }
        float lf = (float)l; asm volatile("" : "+v"(lf));
        const float li = 0.8f - 0.6f * __expf(-0.3f * lf); lam += li;
        float ss = 0.f;
#pragma unroll
        for (int d = 0; d < 4; ++d)
#pragma unroll
            for (int r = 0; r < 16; ++r) { const float v = o[d][r] * il - lam * x1[(32 * d + (r & 3) + 8 * (r >> 2) + 4 * hi) * 32 + q32]; o[d][r] = v; ss += v * v; }
        ss = xor32_sum(ss);
        const float rn = rsqrtf(ss * (1.f / 128.f) + 1e-5f) * (1.f - li);
#pragma unroll
        for (int d = 0; d < 4; ++d)
#pragma unroll
            for (int g = 0; g < 4; ++g) {
                const int dd = 32 * d + 8 * g + 4 * hi;
                bf16_t* gp = gout + qrow * 512 + h * 128 + dd;
                const u32x2 gw = *(const u32x2*)gp;
                const f32x4 sg = *(const f32x4*)(p.in[I_SUBLN] + l * 128 + dd);
                const float v0 = o[d][4 * g + 0] * rn * sg[0] * bf2f(gw.x & 0xffffu), v1 = o[d][4 * g + 1] * rn * sg[1] * bf2f(gw.x >> 16);
                const float v2 = o[d][4 * g + 2] * rn * sg[2] * bf2f(gw.y & 0xffffu), v3 = o[d][4 * g + 3] * rn * sg[3] * bf2f(gw.y >> 16);
                u32x2 ow; ow.x = pk2(v0, v1); ow.y = pk2(v2, v3); *(u32x2*)gp = ow;
            }
    }
    __syncthreads();
}
__device__ __forceinline__ void na_unit(const Params& p, int l, int b, int h, int rb4, bool ctxq, unsigned char* lds) {
    const int tid = otid(), wave = tid >> 6, lane = tid & 63, q32 = lane & 31, hi = lane >> 5;
    const bf16_t* naq = (const bf16_t*)(p.ws + WS_NAQ); bf16_t* gout = (bf16_t*)(p.ws + WS_G3) + (size_t)T * 512;
    float* rpbs = (float*)(lds + AT_RPB);
    size_t qrow; int n1, act_lo = 0, act_hi = 0, na_r = 0, na_c = 0, row_lo = 0;
    if (!ctxq) {
        const int R0 = 4 * rb4, r = R0 + (wave >> 1), c = 32 * (wave & 1) + q32;
        row_lo = min(max(R0 - 4, 0), 56); const int row_hi = min(max(R0 + 3 - 4, 0), 56) + 7;
        n1 = row_hi - row_lo + 1;
        const int rs = min(max(r - 4, 0), 56); act_lo = rs - row_lo; act_hi = act_lo + 8; na_r = r; na_c = c;
        qrow = (size_t)b * SEQ + r * 64 + c;
        for (int i = tid; i < 15 * 31; i += 512) rpbs[i] = p.in[I_RPB][((size_t)(l * 8 + h) * 15) * 31 + i] * LOG2E;
    } else { n1 = 0; qrow = (size_t)TL + b * CTXL + wave * 32 + q32; }
    bf16x8 qf[4];
#pragma unroll
    for (int d0 = 0; d0 < 4; ++d0) qf[d0] = *(const bf16x8*)(naq + qrow * 1536 + h * 64 + 16 * d0 + 8 * hi);
    f32x16 o[2]; float lsum;
    attn_loop<64, 64, true>(lds, naq + 512 + h * 64, naq + 1024 + h * 64, 1536, n1, (size_t)b * SEQ + (size_t)row_lo * 64, n1 + 4, (size_t)TL + b * CTXL,
                            qf, 0, act_lo, act_hi, na_r, na_c, row_lo, rpbs, o, lsum);
    const float il = 1.f / lsum;
#pragma unroll
    for (int d = 0; d < 2; ++d)
#pragma unroll
        for (int g = 0; g < 4; ++g) {
            const int dd = 32 * d + 8 * g + 4 * hi;
            bf16_t* gp = gout + qrow * 512 + h * 64 + dd;
            const u32x2 gw = *(const u32x2*)gp;
            const float v0 = o[d][4 * g + 0] * il * bf2f(gw.x & 0xffffu), v1 = o[d][4 * g + 1] * il * bf2f(gw.x >> 16);
            const float v2 = o[d][4 * g + 2] * il * bf2f(gw.y & 0xffffu), v3 = o[d][4 * g + 3] * il * bf2f(gw.y >> 16);
            u32x2 ow; ow.x = pk2(v0, v1); ow.y = pk2(v2, v3); *(u32x2*)gp = ow;
        }
    __syncthreads();
}

__device__ __forceinline__ void run_gemm(const Params& p, int kind, unsigned char* lds, int G, int c, int mrows = T, bool gated = false, unsigned need = 0u) {
    bf16_t* hx = (bf16_t*)(p.ws + WS_HX); bf16_t* win2 = (bf16_t*)(p.ws + WS_WIN2);
    Epi E; E.mode = kind >= 4 ? 0 : kind; E.pn_off = kind == 5 ? 7 : 0;
    E.zrw = (bf16_t*)(p.ws + WS_ZRW); E.naq = (bf16_t*)(p.ws + WS_NAQ); E.dfq = (bf16_t*)(p.ws + WS_DFQ); E.g3 = (bf16_t*)(p.ws + WS_G3);
    E.sg = (bf16_t*)(p.ws + WS_SG); E.mout = (bf16_t*)(p.ws + WS_M); E.mpart = (float*)(p.ws + WS_MPART); E.ybuf = (bf16_t*)(p.ws + WS_YBUF); E.rope = (const f32x2*)(p.ws + WS_ROPE);
    pg8::Gemm g; Sched S; S.mode = 0; S.G = G; S.c = c; S.npm = mrows / 256; S.ready = nullptr; S.need = 0u;
    if (kind == 4) { g = pg8::Gemm{hx, (const bf16_t*)(p.ws + WS_WINRW), T, 1792, 1024}; S.so.init(T, 1792, G, c); }
    else if (kind == 5) { g = pg8::Gemm{hx, win2, T, 4608, 1024}; S.so.init(T, 4608, G, c); }
    else if (kind == 1) { g = pg8::Gemm{hx, win2 + (size_t)4608 * 1024, mrows, 3072, 1024}; S.so.init(mrows, 3072, G, c); }
    else if (kind == 2) { g = pg8::Gemm{(const bf16_t*)(p.ws + WS_G3), (const bf16_t*)(p.ws + WS_WBR), 3 * T, 3072, 512}; S.mode = 1; S.so.init(T, 1024, G, c); }
    else { g = pg8::Gemm{(const bf16_t*)(p.ws + WS_M), (const bf16_t*)(p.ws + WS_WOUT), mrows, 1024, 1024}; S.so.init(mrows, 1024, G, c); if (gated) { S.mode = 2; S.ready = (const unsigned*)(p.ws + WS_CTL) + 3400; S.need = need; } }
    pg8::gemm_phase<Epi, Sched, true, true>((PG8_LAS unsigned char*)lds, g, S, E);
}

constexpr int NQ_UNITS = 272;
__device__ __forceinline__ void phase_branches(const Params& p, int l, unsigned char* lds) {
    unsigned* gctr = (unsigned*)(p.ws + WS_CTL) + 64 * (40 + l);
    if (blockIdx.x < 128) scan_chain(p, l, blockIdx.x, lds);
    else if (p.ovl) {
        run_gemm(p, 5, lds, (int)gridDim.x - 128, (int)blockIdx.x - 128);
        asm volatile("s_waitcnt vmcnt(0)" ::: "memory");
        __syncthreads();
        if (otid() == 0) { __builtin_amdgcn_fence(__ATOMIC_RELEASE, "agent"); asm volatile("s_waitcnt vmcnt(0)" ::: "memory"); __hip_atomic_fetch_add(gctr, 1u, __ATOMIC_RELAXED, __HIP_MEMORY_SCOPE_AGENT); }
    }
    if (p.ovl) {
        if (otid() == 0) {
            unsigned sp = 0; const unsigned want = gridDim.x - 128;
            while (__hip_atomic_load(gctr, __ATOMIC_RELAXED, __HIP_MEMORY_SCOPE_AGENT) < want) { __builtin_amdgcn_s_sleep(2); if (++sp > (1u << 22)) break; }
            __builtin_amdgcn_fence(__ATOMIC_ACQUIRE, "agent"); asm volatile("s_waitcnt vmcnt(0)" ::: "memory");
        }
        __syncthreads();
    }
    volatile int* slot = (volatile int*)(lds + AT_SLOT);
    for (int kq = 0; kq < 8; ++kq) {
        const int x = (blockIdx.x + kq) & 7;
        unsigned* ctr = (unsigned*)(p.ws + WS_CTL) + 64 * (8 * l + x + 1);
        for (;;) {
            __syncthreads();
            if (otid() == 0) *slot = (int)atomicAdd(ctr, 1u);
            __syncthreads();
            int j = *slot;
            if (j >= NQ_UNITS) break;
            if (j < 128) { const int bh = x + 8 * (j >> 5), b = bh >> 2, h = bh & 3, qb = j & 31; diff_unit(p, l, b, h, (size_t)b * SEQ + qb * 128, 0, lds); continue; }
            j -= 128;
            if (j < 128) { const int bh = x + 8 * (j >> 4), b = bh >> 3, h = bh & 7, rb4 = j & 15; na_unit(p, l, b, h, rb4, false, lds); continue; }
            j -= 128;
            if (j < 8) { const int bh = x + 8 * (j >> 1), b = bh >> 2, h = bh & 3, qb = j & 1; diff_unit(p, l, b, h, (size_t)TL + b * CTXL + qb * 128, 64, lds); continue; }
            j -= 8;
            { const int bh = x + 8 * j, b = bh >> 3, h = bh & 7; na_unit(p, l, b, h, 0, true, lds); }
        }
    }
}


#define XB_TMO      128
#define XB_XCNT(j)  (256  + 64 * (j))
#define XB_XSUB(j)  (1280 + 64 * (j))
#define XB_XGEN(j)  (2304 + 64 * (j))
#define XB_TOP      3328
#define XB_TOPGEN   3392
#define XCD_BAR_WORDS 3456
#define XB_SPIN_CAP (1u << 18)

__device__ __forceinline__ unsigned xb_ld(unsigned* p)              { return __hip_atomic_load(p, __ATOMIC_RELAXED, __HIP_MEMORY_SCOPE_AGENT); }
__device__ __forceinline__ unsigned xb_add(unsigned* p, unsigned v) { return __hip_atomic_fetch_add(p, v, __ATOMIC_RELAXED, __HIP_MEMORY_SCOPE_AGENT); }
__device__ __forceinline__ unsigned xb_xcc_id() { return (unsigned)__builtin_amdgcn_s_getreg((3 << 11) | 20) & 0xFu; }
#define XB_SPIN(cond, bar) do { unsigned _sp = 0; while (cond) { __builtin_amdgcn_s_sleep(1); \
    if ((++_sp & 255u) == 0u) { if (xb_ld(&(bar)[XB_TMO])) break; if (_sp > XB_SPIN_CAP) { atomicAdd(&(bar)[XB_TMO], 1u); break; } } } } while (0)

struct XcdBarrier {
    unsigned* bar; unsigned x;
    volatile LAS unsigned* st;
};

__device__ __forceinline__ XcdBarrier xcd_barrier_post(unsigned* bar, volatile LAS unsigned* st) {
    XcdBarrier b; b.bar = bar; b.x = xb_xcc_id(); b.st = st;
    if (threadIdx.x == 0) (void)xb_add(&bar[XB_XCNT(b.x)], 1u);
    return b;
}
__device__ __forceinline__ void xcd_barrier_complete(unsigned* bar, unsigned x, unsigned& nloc, unsigned& nx) {
    const unsigned G = gridDim.x * gridDim.y * gridDim.z;
    unsigned sum, cnt, mine, sp = 0u;
    for (;;) {
        sum = 0u; cnt = 0u; mine = 0u;
#pragma unroll
        for (unsigned j = 0; j < 16; ++j) { const unsigned c = xb_ld(&bar[XB_XCNT(j)]); sum += c; cnt += (c > 0u) ? 1u : 0u; mine = (j == x) ? c : mine; }
        if (sum == G) break;
        __builtin_amdgcn_s_sleep(1);
        if ((++sp & 255u) == 0u) { if (xb_ld(&bar[XB_TMO])) break; if (sp > XB_SPIN_CAP) { atomicAdd(&bar[XB_TMO], 1u); break; } }
    }
    nloc = mine > 0u ? mine : 1u; nx = cnt > 0u ? cnt : 1u;
}

__device__ __forceinline__ void xcd_barrier(const XcdBarrier& b) {
    asm volatile("s_waitcnt vmcnt(0)" ::: "memory");
    __syncthreads();
    if (threadIdx.x == 0) {
        unsigned* bar = b.bar;
        __builtin_amdgcn_s_waitcnt(0);
        unsigned nloc = b.st[0], nx = b.st[1];
        if (nloc == 0u) { xcd_barrier_complete(bar, b.x, nloc, nx); b.st[0] = nloc; b.st[1] = nx; }
        const unsigned old = xb_add(&bar[XB_XSUB(b.x)], 1u);
        const unsigned gen = old / nloc;
        if (old + 1u == (gen + 1u) * nloc) {
            __builtin_amdgcn_fence(__ATOMIC_RELEASE, "agent");
            asm volatile("s_waitcnt vmcnt(0)" ::: "memory");
            const unsigned og = xb_add(&bar[XB_TOP], 1u);
            const unsigned tg = og / nx;
            if (og + 1u == (tg + 1u) * nx) xb_add(&bar[XB_TOPGEN], 1u);
            else XB_SPIN(xb_ld(&bar[XB_TOPGEN]) == tg, bar);
            __builtin_amdgcn_fence(__ATOMIC_ACQUIRE, "agent");
            xb_add(&bar[XB_XGEN(b.x)], 1u);
            asm volatile("s_waitcnt vmcnt(0)" ::: "memory");
        } else {
            XB_SPIN(xb_ld(&bar[XB_XGEN(b.x)]) == gen, bar);
            __builtin_amdgcn_fence(__ATOMIC_ACQUIRE, "agent");
            asm volatile("s_waitcnt vmcnt(0)" ::: "memory");
        }
    }
    __syncthreads();
}


__global__ void __launch_bounds__(512, 2) mega_fwd(Params p) {
    extern __shared__ __attribute__((aligned(16))) unsigned char lds[];
    cg::grid_group grid = cg::this_grid();
    volatile LAS unsigned* bst = (volatile LAS unsigned*)((LAS unsigned char*)lds + LDS_BYTES - 64);
    if (threadIdx.x < 2) bst[threadIdx.x] = 0u;
    __syncthreads();
    XcdBarrier bar = xcd_barrier_post((unsigned*)(p.ws + WS_CTL) + 4096, bst);
    for (int ph = p.ph_lo; ph < p.ph_hi; ++ph) {
        if (p.ovl && ph > 0 && ph < NPHASE - 1 && ((ph - 1) % 7 == 4 || (ph - 1) % 7 == 6)) continue;
        if (ph == p.ph_lo + 1) grid.sync();
        else if (ph > p.ph_lo) xcd_barrier(bar);
        if (ph == 0) {
#ifndef NO_PRO
 phase_prologue(p, lds);
#endif
 continue; }
        if (ph == NPHASE - 1) { phase_rowpass(p, DEPTH); continue; }
        const int l = (ph - 1) / 7, s = (ph - 1) % 7;
        if (s == 0) {
#ifndef NO_ROW
 if (l > 0) convert_weights(p, l, lds); phase_rowpass(p, l);
#endif
 }
        else if (s == 1) {
#ifndef NO_GEMM
 run_gemm(p, 4, lds, gridDim.x, blockIdx.x); if (!p.ovl) { __syncthreads(); run_gemm(p, 5, lds, gridDim.x, blockIdx.x); }
#endif
 }
        else if (s == 2) {
#ifndef NO_BR
 phase_branches(p, l, lds);
#endif
 }
        else if (s == 3) {
#ifndef NO_RO
 if (p.ovl) { run_gemm(p, 1, lds, gridDim.x, blockIdx.x, l == DEPTH - 1 ? TL : T); __syncthreads(); phase_readout(p, l, true); } else phase_readout(p, l, false);
#endif
 }
        else {
#ifndef NO_GEMM
 const int mrows_ = l == DEPTH - 1 ? TL : T;
 run_gemm(p, s - 3, lds, gridDim.x, blockIdx.x, mrows_);
 if (p.ovl && s == 5) {
     asm volatile("s_waitcnt vmcnt(0)" ::: "memory");
     __syncthreads();
     if (otid() == 0) {
         __builtin_amdgcn_fence(__ATOMIC_RELEASE, "agent"); asm volatile("s_waitcnt vmcnt(0)" ::: "memory");
         unsigned* pc = (unsigned*)(p.ws + WS_CTL) + 3400;
         for (int k = 0; k < 3; ++k) { const int pm = ((int)blockIdx.x & 7) + 8 * ((int)blockIdx.x >> 5) + 64 * k; if (pm < mrows_ / 256) __hip_atomic_fetch_add(pc + pm, 1u, __ATOMIC_RELAXED, __HIP_MEMORY_SCOPE_AGENT); }
     }
     __syncthreads();
     run_gemm(p, 3, lds, gridDim.x, blockIdx.x, mrows_, true, 4u * (unsigned)(l + 1));
 }
#endif
 }
        __syncthreads();
    }
}

#ifndef N_LAUNCH_MODE
#define N_LAUNCH_MODE 1
#endif
extern "C" void kernel_launch(void* const* d_in, const int* in_sizes, int n_in, void* d_out, int out_size, void* d_ws, size_t ws_size, hipStream_t stream) {
    static int grid = 0;
    if (grid == 0) {
        if (n_in != 25 || out_size != TL * DM || ws_size < WS_END) { fprintf(stderr, "kernel_launch: unexpected sizes n_in %d out %d ws %zu\n", n_in, out_size, ws_size); grid = -1; return; }
        int dev = 0, cus = 0, per_cu = 0;
        hipGetDevice(&dev); hipDeviceGetAttribute(&cus, hipDeviceAttributeMultiprocessorCount, dev);
        hipFuncSetAttribute((const void*)mega_fwd, hipFuncAttributeMaxDynamicSharedMemorySize, LDS_BYTES);
        hipOccupancyMaxActiveBlocksPerMultiprocessor(&per_cu, (const void*)mega_fwd, 512, LDS_BYTES);
        (void)hipGetLastError();
        if (per_cu < 1) per_cu = 1;
        grid = cus;
        if (grid > cus * per_cu) grid = cus * per_cu;
        if (grid != 256) { fprintf(stderr, "kernel_launch: built for a 256-CU device (grid %d)\n", grid); grid = -1; return; }
    }
    if (grid < 0) return;
    hipMemsetAsync((char*)d_ws + WS_CTL, 0, 32768, stream);
    Params a{};
    for (int i = 0; i < 25; ++i) a.in[i] = (const float*)d_in[i];
    a.out = (float*)d_out; a.ws = (unsigned char*)d_ws; a.ovl = (ws_size >= WS_END2 && grid == 256) ? 1 : 0;
#if N_LAUNCH_MODE == 1
    a.ph_lo = 0; a.ph_hi = NPHASE;
    void* args[] = {&a};
    hipError_t e = hipLaunchCooperativeKernel((const void*)mega_fwd, dim3(grid), dim3(512), args, LDS_BYTES, stream);
    if (e != hipSuccess) fprintf(stderr, "cooperative launch failed: %s (grid %d)\n", hipGetErrorString(e), grid);
#else
    for (int ph = 0; ph < NPHASE; ++ph) { a.ph_lo = ph; a.ph_hi = ph + 1; hipLaunchKernelGGL(mega_fwd, dim3(grid), dim3(512), LDS_BYTES, stream, a); }
#endif
}
```
